# Optimizing an MI355X kernel written in HIP

```python
import math
import jax, jax.numpy as jnp
from jax import lax
import numpy as np

D_MODEL = 2048
BATCH = 4
SEQ = 4096
DEPTH = 1

GRID_W = 64
CTX_LEN = 256
SSD_HEADS = 32
SSD_HEAD_DIM = 64
SSD_INNER = SSD_HEADS * SSD_HEAD_DIM
SSD_GROUPS = 4
SSD_HPG = SSD_HEADS // SSD_GROUPS
SSD_STATE = 128
SSD_CONV = 3
CHUNK = 128
SSD_XBC = SSD_INNER + 2 * SSD_GROUPS * SSD_STATE
SC_DIM = 2048
SC_CONV = 3
N_EXPERTS = 16
EXPERT_FF = 2048
CAPACITY_FACTOR = 2
EPS = 1e-6
PROJ_OFFSETS = (
    SSD_INNER,
    SSD_INNER + SSD_XBC,
    SSD_INNER + SSD_XBC + 2 * SSD_HEADS,
    SSD_INNER + SSD_XBC + 2 * SSD_HEADS + SC_DIM,
    SSD_INNER + SSD_XBC + 2 * SSD_HEADS + 2 * SC_DIM,
    SSD_INNER + SSD_XBC + 2 * SSD_HEADS + 3 * SC_DIM,
)
PROJ_COLS = SSD_INNER + SSD_XBC + 2 * SSD_HEADS + 3 * SC_DIM + 2 * D_MODEL

kernel_name = "hybrid_ssd_shortconv_ecmoe_dit_block"


def rmsnorm(x, w):
    x32 = x.astype(jnp.float32)
    y = x32 * lax.rsqrt(jnp.mean(x32 * x32, axis=-1, keepdims=True) + EPS)
    return (y * w.astype(jnp.float32)).astype(x.dtype)


def rev(a):
    return jnp.flip(a, axis=1)


def dwconv(x, w, b=None):
    k_w = w.shape[0]
    pad = k_w // 2
    length = x.shape[1]
    xp = jnp.pad(x, ((0, 0), (pad, pad), (0, 0)))
    y = sum(xp[:, k:k + length] * w[k] for k in range(k_w))
    return y if b is None else y + b


def seq_conv(x, w, b, grid):
    if grid:
        bsz, length, ch = x.shape
        rows = length // GRID_W
        return dwconv(x.reshape(bsz * rows, GRID_W, ch), w, b).reshape(bsz, length, ch)
    return dwconv(x, w, b)


def ssd_prep(xbc, dt_raw, p, grid):
    bsz, length, _ = xbc.shape
    xbc = jax.nn.silu(seq_conv(xbc, p['ssd_conv_w'], p['ssd_conv_b'], grid))
    xs, bm, cm = jnp.split(xbc, [SSD_INNER, SSD_INNER + SSD_GROUPS * SSD_STATE], axis=-1)
    xs = xs.reshape(bsz, length, SSD_GROUPS, SSD_HPG, SSD_HEAD_DIM)
    bm = bm.reshape(bsz, length, SSD_GROUPS, SSD_STATE)
    cm = cm.reshape(bsz, length, SSD_GROUPS, SSD_STATE)
    dt = jax.nn.softplus(dt_raw.astype(jnp.float32).reshape(bsz, length, 2, SSD_HEADS)
                         + p['dt_bias'].astype(jnp.float32))
    dt = dt.reshape(bsz, length, 2, SSD_GROUPS, SSD_HPG)
    a = -jnp.exp(p['a_log'].astype(jnp.float32)).reshape(2, SSD_GROUPS, SSD_HPG)
    return xs, bm, cm, dt, a


def ssd_chunk_states(xs, dt, a, bm, h0):
    bsz, length = xs.shape[:2]
    nc = length // CHUNK
    xc = xs.reshape(bsz, nc, CHUNK, SSD_GROUPS, SSD_HPG, SSD_HEAD_DIM)
    dtc = dt.reshape(bsz, nc, CHUNK, SSD_GROUPS, SSD_HPG)
    bc = bm.reshape(bsz, nc, CHUNK, SSD_GROUPS, SSD_STATE)
    acs = jnp.cumsum(dtc * a, axis=2)
    decay_to_end = jnp.exp(acs[:, :, -1:] - acs)
    s = jnp.einsum('bcjgr,bcjgn,bcjgrp->bcgrpn', decay_to_end * dtc, bc, xc)
    chunk_decay = jnp.exp(acs[:, :, -1])

    def step(h, inp):
        dec, s_c = inp
        return dec[..., None, None] * h + s_c, h

    h_final, h_enter = lax.scan(step, h0,
                                (jnp.moveaxis(chunk_decay, 1, 0), jnp.moveaxis(s, 1, 0)))
    return acs, jnp.moveaxis(h_enter, 0, 1), h_final


def ssd_scan(xs, dt, a, bm, cm, h0):
    bsz, length = xs.shape[:2]
    nc = length // CHUNK
    acs, h_enter, h_final = ssd_chunk_states(xs, dt, a, bm, h0)
    xc = xs.reshape(bsz, nc, CHUNK, SSD_GROUPS, SSD_HPG, SSD_HEAD_DIM)
    dtc = dt.reshape(bsz, nc, CHUNK, SSD_GROUPS, SSD_HPG)
    bc = bm.reshape(bsz, nc, CHUNK, SSD_GROUPS, SSD_STATE)
    cc = cm.reshape(bsz, nc, CHUNK, SSD_GROUPS, SSD_STATE)
    cb = jnp.einsum('bcign,bcjgn->bcgij', cc, bc)
    at = jnp.moveaxis(acs, 2, -1)
    seg = at[..., :, None] - at[..., None, :]
    mask = jnp.tril(jnp.ones((CHUNK, CHUNK), dtype=bool))
    lmat = jnp.exp(jnp.where(mask, seg, -jnp.inf))
    m = cb[:, :, :, None] * lmat * jnp.moveaxis(dtc, 2, -1)[..., None, :]
    y_diag = jnp.einsum('bcgrij,bcjgrp->bcigrp', m, xc)
    y_off = jnp.einsum('bcign,bcgrpn->bcigrp', cc, h_enter) * jnp.exp(acs)[..., None]
    y = (y_diag + y_off).reshape(bsz, length, SSD_GROUPS, SSD_HPG, SSD_HEAD_DIM)
    return y, h_final


def token_mixer(h, states, p, grid):
    bsz, length, _ = h.shape
    proj = h @ p['w_in']
    z, xbc, dt_raw, sc_b, sc_c, sc_v, g_raw = jnp.split(proj, PROJ_OFFSETS, axis=-1)
    xs, bm, cm, dt, a = ssd_prep(xbc, dt_raw, p, grid)
    h0_f, h0_b = states
    y_f, hf_f = ssd_scan(xs, dt[:, :, 0], a[0], bm, cm, h0_f)
    y_b, hf_b = ssd_scan(rev(xs), rev(dt[:, :, 1]), a[1], rev(bm), rev(cm), h0_b)
    y = y_f + rev(y_b) + p['ssd_d'].reshape(SSD_GROUPS, SSD_HPG)[..., None] * xs
    y = y.reshape(bsz, length, SSD_INNER) * jax.nn.silu(z)
    y = rmsnorm(y.reshape(bsz, length, SSD_GROUPS, -1),
                p['ssd_norm_w'].reshape(SSD_GROUPS, -1)).reshape(bsz, length, SSD_INNER)
    ssd_out = y.astype(h.dtype) @ p['w_ssd_out']
    sc_y = sc_b * seq_conv(sc_c * sc_v, p['sc_conv_w'], None, grid)
    sc_out = sc_y @ p['w_sc_out']
    g_ssd, g_sc = jnp.split(jax.nn.sigmoid(g_raw + p['b_gate']), 2, axis=-1)
    merged = g_ssd * ssd_out + g_sc * sc_out
    return (merged @ p['w_o']).astype(h.dtype), (hf_f, hf_b)


def ctx_final_states(hc, p):
    cols = hc @ p['w_in'][:, SSD_INNER:SSD_INNER + SSD_XBC + 2 * SSD_HEADS]
    xbc, dt_raw = jnp.split(cols, [SSD_XBC], axis=-1)
    xs, bm, _, dt, a = ssd_prep(xbc, dt_raw, p, False)
    h0 = jnp.zeros((hc.shape[0], SSD_GROUPS, SSD_HPG, SSD_HEAD_DIM, SSD_STATE), jnp.float32)
    hf_f = ssd_chunk_states(xs, dt[:, :, 0], a[0], bm, h0)[2]
    hf_b = ssd_chunk_states(rev(xs), rev(dt[:, :, 1]), a[1], rev(bm), h0)[2]
    return (hf_f, hf_b)


def expert_choice_ffn(h, p):
    bsz, n, d = h.shape
    cap = CAPACITY_FACTOR * n // N_EXPERTS
    aff = jax.nn.softmax((h @ p['w_router']).astype(jnp.float32), axis=-1)
    vals, idx = lax.top_k(jnp.swapaxes(aff, 1, 2), cap)
    xg = jax.vmap(lambda hb, ib: hb[ib])(h, idx)
    g = jnp.einsum('becd,edf->becf', xg, p['w_e1'])
    u = jnp.einsum('becd,edf->becf', xg, p['w_e3'])
    out = jnp.einsum('becf,efd->becd', jax.nn.silu(g) * u, p['w_e2'])
    out = out * vals[..., None].astype(out.dtype)
    y = jax.vmap(lambda ib, ob: jnp.zeros((n, d), ob.dtype).at[ib.reshape(-1)].add(ob.reshape(-1, d)))(idx, out)
    return y.astype(h.dtype)


def modulate(h, shift, scale):
    return h * (1 + scale) + shift


def layer(x, ctx, c, c_ctx, p, last):
    mod_x = (jax.nn.silu(c) @ p['w_mod'] + p['b_mod'])[:, None, :]
    mod_c = jax.nn.silu(c_ctx) @ p['w_mod'] + p['b_mod']
    shx, scx, gx, shfx, scfx, gfx = jnp.split(mod_x, 6, axis=-1)
    shc, scc, gc, shfc, scfc, gfc = jnp.split(mod_c, 6, axis=-1)
    hc = modulate(rmsnorm(ctx, p['norm_pre_mix']), shc, scc)
    if last:
        states = ctx_final_states(hc, p)
    else:
        h0 = jnp.zeros((ctx.shape[0], SSD_GROUPS, SSD_HPG, SSD_HEAD_DIM, SSD_STATE), jnp.float32)
        out_c, states = token_mixer(hc, (h0, h0), p, False)
        ctx = ctx + gc * rmsnorm(out_c, p['norm_post_mix'])
        hc2 = modulate(rmsnorm(ctx, p['norm_pre_ffn']), shfc, scfc)
        ctx = ctx + gfc * rmsnorm(expert_choice_ffn(hc2, p), p['norm_post_ffn'])
    hx = modulate(rmsnorm(x, p['norm_pre_mix']), shx, scx)
    out_x, _ = token_mixer(hx, states, p, True)
    x = x + gx * rmsnorm(out_x, p['norm_post_mix'])
    hx2 = modulate(rmsnorm(x, p['norm_pre_ffn']), shfx, scfx)
    x = x + gfx * rmsnorm(expert_choice_ffn(hx2, p), p['norm_post_ffn'])
    return x, ctx


def setup_inputs(seed: int = 0) -> dict:
    key = jax.random.key(seed)
    ks = jax.random.split(key, 32)
    f32 = jnp.float32

    def nrm(k, shape, scale):
        return jax.random.normal(k, shape, f32) * scale

    def gain(k, shape):
        return 1.0 + 0.05 * jax.random.normal(k, shape, f32)

    u = jax.random.uniform(ks[10], (DEPTH, 2, SSD_HEADS), f32)
    dt0 = jnp.exp(u * (math.log(0.1) - math.log(0.001)) + math.log(0.001))
    dt_bias = dt0 + jnp.log(-jnp.expm1(-dt0))
    a_log = jnp.log(jax.random.uniform(ks[11], (DEPTH, 2, SSD_HEADS), f32, minval=1.0, maxval=16.0))
    return {
        'x': nrm(ks[0], (BATCH, SEQ, D_MODEL), 1.0),
        'c': nrm(ks[1], (BATCH, D_MODEL), 1.0),
        'ctx': nrm(ks[2], (BATCH, CTX_LEN, D_MODEL), 1.0),
        'c_ctx': nrm(ks[3], (D_MODEL,), 1.0),
        'w_mod': nrm(ks[4], (DEPTH, D_MODEL, 6 * D_MODEL), 0.3 * D_MODEL ** -0.5),
        'b_mod': nrm(ks[5], (DEPTH, 6 * D_MODEL), 0.02),
        'norm_pre_mix': gain(ks[6], (DEPTH, D_MODEL)),
        'norm_post_mix': gain(ks[7], (DEPTH, D_MODEL)),
        'w_in': nrm(ks[8], (DEPTH, D_MODEL, PROJ_COLS), D_MODEL ** -0.5),
        'ssd_conv_w': nrm(ks[9], (DEPTH, SSD_CONV, SSD_XBC), SSD_CONV ** -0.5),
        'ssd_conv_b': nrm(ks[12], (DEPTH, SSD_XBC), 0.02),
        'dt_bias': dt_bias,
        'a_log': a_log,
        'ssd_d': gain(ks[13], (DEPTH, SSD_HEADS)),
        'ssd_norm_w': gain(ks[14], (DEPTH, SSD_INNER)),
        'w_ssd_out': nrm(ks[15], (DEPTH, SSD_INNER, D_MODEL), SSD_INNER ** -0.5),
        'sc_conv_w': nrm(ks[16], (DEPTH, SC_CONV, SC_DIM), SC_CONV ** -0.5),
        'w_sc_out': nrm(ks[17], (DEPTH, SC_DIM, D_MODEL), SC_DIM ** -0.5),
        'b_gate': nrm(ks[18], (DEPTH, 2 * D_MODEL), 0.02),
        'w_o': nrm(ks[19], (DEPTH, D_MODEL, D_MODEL), D_MODEL ** -0.5),
        'norm_pre_ffn': gain(ks[20], (DEPTH, D_MODEL)),
        'norm_post_ffn': gain(ks[21], (DEPTH, D_MODEL)),
        'w_router': nrm(ks[22], (DEPTH, D_MODEL, N_EXPERTS), D_MODEL ** -0.5),
        'w_e1': nrm(ks[23], (DEPTH, N_EXPERTS, D_MODEL, EXPERT_FF), D_MODEL ** -0.5),
        'w_e3': nrm(ks[24], (DEPTH, N_EXPERTS, D_MODEL, EXPERT_FF), D_MODEL ** -0.5),
        'w_e2': nrm(ks[25], (DEPTH, N_EXPERTS, EXPERT_FF, D_MODEL), EXPERT_FF ** -0.5),
    }


def reference(x, c, ctx, c_ctx, w_mod, b_mod, norm_pre_mix, norm_post_mix, w_in, ssd_conv_w,
              ssd_conv_b, dt_bias, a_log, ssd_d, ssd_norm_w, w_ssd_out, sc_conv_w, w_sc_out,
              b_gate, w_o, norm_pre_ffn, norm_post_ffn, w_router, w_e1, w_e3, w_e2):
    for l in range(DEPTH):
        p = {
            'w_mod': w_mod[l], 'b_mod': b_mod[l],
            'norm_pre_mix': norm_pre_mix[l], 'norm_post_mix': norm_post_mix[l],
            'w_in': w_in[l], 'ssd_conv_w': ssd_conv_w[l], 'ssd_conv_b': ssd_conv_b[l],
            'dt_bias': dt_bias[l], 'a_log': a_log[l], 'ssd_d': ssd_d[l],
            'ssd_norm_w': ssd_norm_w[l], 'w_ssd_out': w_ssd_out[l],
            'sc_conv_w': sc_conv_w[l], 'w_sc_out': w_sc_out[l],
            'b_gate': b_gate[l], 'w_o': w_o[l],
            'norm_pre_ffn': norm_pre_ffn[l], 'norm_post_ffn': norm_post_ffn[l],
            'w_router': w_router[l], 'w_e1': w_e1[l], 'w_e3': w_e3[l], 'w_e2': w_e2[l],
        }
        x, ctx = layer(x, ctx, c, c_ctx, p, l == DEPTH - 1)
    return x
```

```cpp
#include <hip/hip_runtime.h>
#include <cstdio>
#include <cstdint>
namespace pg8 {
#define PG8_LAS __attribute__((address_space(3)))
typedef unsigned short bf16_t;
typedef short bf16x8 __attribute__((ext_vector_type(8)));
typedef float f32x4 __attribute__((ext_vector_type(4)));
typedef unsigned u32x4 __attribute__((ext_vector_type(4)));
constexpr int BM = 256, BK = 64, HALF = 128, HTB = HALF * BK * 2  , STAGE_BYTES = 8 * HTB, NXCD = 8, WGM = 8;

__host__ __device__ __forceinline__ int lds_byte(int r, int c) { const int st = (r >> 4) * 2 + (c >> 5), rr = r & 15, cc = c & 31, ob = rr * 64 + cc * 2; return st * 1024 + (ob ^ (((ob >> 9) & 1) << 5)); }
__host__ __device__ __forceinline__ void stage_rc(int b, int& R, int& C) { const int st = b / 1024, sb = b % 1024, swz = sb ^ (((sb >> 9) & 1) << 5); R = (st >> 1) * 16 + swz / 64; C = (st & 1) * 32 + (swz % 64) / 2; }
__host__ __device__ __forceinline__ int perm32(int rho) { const int n = rho >> 4, i = rho & 15; return 8 * (i >> 2) + 4 * n + (i & 3); }

struct Unit { int pm, pn; int sel = 0; };
struct Gemm { const bf16_t* A; const bf16_t* Bt; int M, N, K; const bf16_t* A2 = nullptr; const bf16_t* Bt2 = nullptr; };

struct StaticOrder {
    static constexpr bool DYNAMIC = false;
    int nM, nN, nwg, G, c;
    __host__ __device__ __forceinline__ void init(int M, int N, int G_, int c_) { nM = M / BM; nN = N / BM; nwg = nM * nN; G = G_; c = c_; }
    __host__ __device__ __forceinline__ bool next(int i, Unit& u) const {
        const long L = (long)i * G + c; if (L >= nwg) return false;
        int wgid = (int)L; { const int q = nwg / NXCD, r = nwg % NXCD, xcd = wgid % NXCD, off = wgid / NXCD; wgid = (xcd < r ? xcd * (q + 1) : r * (q + 1) + (xcd - r) * q) + off; }
        const int nig = WGM * nN, gid = wgid / nig, fm = gid * WGM, gsz = (nM - fm) < WGM ? (nM - fm) : WGM;
        u.pm = fm + ((wgid % nig) % gsz); u.pn = (wgid % nig) / gsz; return true;
    }
    __device__ __forceinline__ void a_ready(const Unit&) const {}
    __device__ __forceinline__ void done(const Unit&) const {}
};

__device__ __forceinline__ unsigned cvt_pk_bf16(float lo, float hi) { unsigned r; asm volatile("v_cvt_pk_bf16_f32 %0, %1, %2" : "=v"(r) : "v"(lo), "v"(hi)); return r; }
typedef float f32x2 __attribute__((ext_vector_type(2)));
template <class Epi, class Sched, bool ALIGN_EPI = false, bool SP2 = false>
__device__ __forceinline__ void gemm_phase(PG8_LAS unsigned char* lds, const Gemm g, const Sched& S, const Epi& E) {
    const int tid = threadIdx.x, wid = __builtin_amdgcn_readfirstlane(tid >> 6), lane = tid & 63, wr = wid >> 2, wc = wid & 3, fr = lane & 15, fq = lane >> 4;
    const int K = g.K, nt = K / BK;
    unsigned voffA[2], voffB[2];
#pragma unroll
    for (int i = 0; i < 2; ++i) { int R, C; stage_rc(tid * 16 + i * 8192, R, C); const int Rb = Epi::PERM ? ((R & ~31) + perm32(R & 31)) : R;
        voffA[i] = (unsigned)(R * K + C) * 2u; voffB[i] = (unsigned)(Rb * K + C) * 2u; }
    const size_t kstep = (size_t)(BK * 2);
    const size_t hstep = (size_t)HALF * K * 2;
    const size_t tstep = 2 * hstep;
    const unsigned ldsw = (unsigned)wid * 1024u;
    const int aoff = lds_byte(wr * 64 + fr, fq * 8), boff = lds_byte(wc * 32 + fr, fq * 8);
#define PG8_SA(b, h) (((b) * 2 + (h)) * HTB)
#define PG8_SB(b, h) ((4 + (b) * 2 + (h)) * HTB)
#define PG8_STAGE(bufoff, gbase, voff) do { _Pragma("unroll") for (int _i = 0; _i < 2; ++_i) \
        __builtin_amdgcn_global_load_lds((const unsigned*)((const char*)(gbase) + (voff)[_i]), (PG8_LAS unsigned*)(lds + (bufoff) + ldsw + _i * 8192), 16, 0, 0); } while (0)
#define PG8_LDA(dst, b, h) do { _Pragma("unroll") for (int m = 0; m < 4; ++m) _Pragma("unroll") for (int k = 0; k < 2; ++k) dst[m][k] = *(const PG8_LAS bf16x8*)(lds + PG8_SA(b, h) + aoff + m * 2048 + k * 1024); } while (0)
#define PG8_LDB(dst, b, h) do { _Pragma("unroll") for (int n = 0; n < 2; ++n) _Pragma("unroll") for (int k = 0; k < 2; ++k) dst[n][k] = *(const PG8_LAS bf16x8*)(lds + PG8_SB(b, h) + boff + n * 2048 + k * 1024); } while (0)
#define PG8_MMA(ai, bj, At, Bt) do { __builtin_amdgcn_s_setprio(1); _Pragma("unroll") for (int m = 0; m < 4; ++m) _Pragma("unroll") for (int n = 0; n < 2; ++n) _Pragma("unroll") for (int k = 0; k < 2; ++k) \
        acc[ai][bj][m][n] = __builtin_amdgcn_mfma_f32_16x16x32_bf16(Bt[n][k], At[m][k], acc[ai][bj][m][n], 0, 0, 0); __builtin_amdgcn_s_setprio(0); } while (0)
#define PG8_WAIT_V(n) asm volatile("s_waitcnt vmcnt(" #n ")" ::: "memory")
#define PG8_WAIT_L(n) asm volatile("s_waitcnt lgkmcnt(" #n ")" ::: "memory")
#define PG8_BAR __builtin_amdgcn_s_barrier()
#define PG8_SCHED __builtin_amdgcn_sched_barrier(0)
    Unit cur, nxt; int ui = 0;
    if (!S.next(0, cur)) return;
    f32x4 acc[2][2][4][2];
#pragma unroll
    for (int a = 0; a < 2; ++a)
#pragma unroll
        for (int b = 0; b < 2; ++b)
#pragma unroll
            for (int m = 0; m < 4; ++m)
#pragma unroll
                for (int n = 0; n < 2; ++n) acc[a][b][m][n] = (f32x4){0.f, 0.f, 0.f, 0.f};
    bf16x8 At[4][2], B0[2][2], B1[2][2];
    const char* cA = (const char*)(cur.sel ? g.A2 : g.A) + (size_t)cur.pm * tstep; const char* cB = (const char*)(cur.sel ? g.Bt2 : g.Bt) + (size_t)cur.pn * tstep;
    S.a_ready(cur);
    if constexpr (SP2) {
        PG8_STAGE(PG8_SB(0, 0), cB, voffB); PG8_STAGE(PG8_SB(0, 1), cB + hstep, voffB); PG8_STAGE(PG8_SA(0, 0), cA, voffA); PG8_STAGE(PG8_SA(0, 1), cA + hstep, voffA);
        if (wr == 1) PG8_BAR;
        PG8_WAIT_V(2); PG8_BAR;
        PG8_STAGE(PG8_SB(1, 0), cB + kstep, voffB); PG8_STAGE(PG8_SA(1, 0), cA + kstep, voffA); PG8_STAGE(PG8_SB(1, 1), cB + hstep + kstep, voffB);
        PG8_WAIT_V(6); PG8_BAR;
    } else {
        PG8_STAGE(PG8_SB(0, 0), cB, voffB); PG8_STAGE(PG8_SA(0, 0), cA, voffA); PG8_STAGE(PG8_SB(0, 1), cB + hstep, voffB); PG8_STAGE(PG8_SA(0, 1), cA + hstep, voffA);
        if (wr == 1) PG8_BAR;
        PG8_WAIT_V(4); PG8_BAR;
        PG8_STAGE(PG8_SB(1, 0), cB + kstep, voffB); PG8_STAGE(PG8_SA(1, 0), cA + kstep, voffA); PG8_STAGE(PG8_SB(1, 1), cB + hstep + kstep, voffB);
        PG8_WAIT_V(6); PG8_BAR;
    }
    for (;;) {
        const bool has_next = S.next(ui + 1, nxt);
        unsigned pend = 0u; if constexpr (Sched::DYNAMIC) pend = S.claim_issue(wid, lane);
        const char* nA = has_next ? (const char*)(nxt.sel ? g.A2 : g.A) + (size_t)nxt.pm * tstep : cA; const char* nB = has_next ? (const char*)(nxt.sel ? g.Bt2 : g.Bt) + (size_t)nxt.pn * tstep : cB;
        for (int t = 0; t < nt; t += 2) {
            const bool last = (t == nt - 2);
            const char* a1 = cA + (size_t)(t + 1) * kstep;
            const char* a2 = last ? nA : cA + (size_t)(t + 2) * kstep; const char* b2 = last ? nB : cB + (size_t)(t + 2) * kstep;
            const char* a3 = a2 + kstep; const char* b3 = b2 + kstep;
            if (last && has_next) S.a_ready(nxt);
            if constexpr (SP2) {
            PG8_LDB(B0, 0, 0); PG8_LDB(B1, 0, 1); PG8_SCHED; PG8_LDA(At, 0, 0); PG8_STAGE(PG8_SA(1, 1), a1 + hstep, voffA);
            PG8_WAIT_V(8); PG8_WAIT_L(0); PG8_BAR; PG8_MMA(0, 0, At, B0); PG8_MMA(0, 1, At, B1); PG8_BAR; PG8_SCHED;
            PG8_LDA(At, 0, 1); PG8_STAGE(PG8_SB(0, 0), b2, voffB); PG8_STAGE(PG8_SB(0, 1), b2 + hstep, voffB); PG8_STAGE(PG8_SA(0, 0), a2, voffA);
            PG8_WAIT_V(8); PG8_WAIT_L(0); PG8_BAR; PG8_MMA(1, 0, At, B0); PG8_MMA(1, 1, At, B1); PG8_BAR; PG8_SCHED;
            PG8_LDB(B0, 1, 0); PG8_LDB(B1, 1, 1); PG8_SCHED; PG8_LDA(At, 1, 0); PG8_STAGE(PG8_SA(0, 1), a2 + hstep, voffA);
            PG8_WAIT_V(8); PG8_WAIT_L(0); PG8_BAR; PG8_MMA(0, 0, At, B0); PG8_MMA(0, 1, At, B1); PG8_BAR; PG8_SCHED;
            PG8_LDA(At, 1, 1); PG8_STAGE(PG8_SB(1, 0), b3, voffB); PG8_STAGE(PG8_SB(1, 1), b3 + hstep, voffB); PG8_STAGE(PG8_SA(1, 0), a3, voffA);
            PG8_WAIT_V(8); PG8_WAIT_L(0); PG8_BAR; PG8_MMA(1, 0, At, B0); PG8_MMA(1, 1, At, B1); PG8_BAR; PG8_SCHED;
            } else {
            PG8_LDB(B0, 0, 0); PG8_SCHED; PG8_LDA(At, 0, 0); PG8_STAGE(PG8_SA(1, 1), a1 + hstep, voffA);
            PG8_WAIT_L(8); PG8_BAR; PG8_WAIT_L(0); PG8_MMA(0, 0, At, B0); PG8_BAR; PG8_SCHED;
            PG8_LDB(B1, 0, 1); PG8_STAGE(PG8_SB(0, 0), b2, voffB);
            PG8_BAR; PG8_WAIT_L(0); PG8_MMA(0, 1, At, B1); PG8_BAR;
            PG8_LDA(At, 0, 1); PG8_STAGE(PG8_SA(0, 0), a2, voffA);
            PG8_BAR; PG8_WAIT_L(0); PG8_MMA(1, 0, At, B0); PG8_BAR; PG8_SCHED;
            PG8_STAGE(PG8_SB(0, 1), b2 + hstep, voffB);
            PG8_WAIT_V(6); PG8_BAR; PG8_MMA(1, 1, At, B1); PG8_BAR;
            PG8_LDB(B0, 1, 0); PG8_SCHED; PG8_LDA(At, 1, 0); PG8_STAGE(PG8_SA(0, 1), a2 + hstep, voffA);
            PG8_WAIT_L(8); PG8_BAR; PG8_WAIT_L(0); PG8_MMA(0, 0, At, B0); PG8_BAR; PG8_SCHED;
            PG8_LDB(B1, 1, 1); PG8_STAGE(PG8_SB(1, 0), b3, voffB);
            PG8_BAR; PG8_WAIT_L(0); PG8_MMA(0, 1, At, B1); PG8_BAR;
            PG8_LDA(At, 1, 1); PG8_STAGE(PG8_SA(1, 0), a3, voffA);
            PG8_BAR; PG8_WAIT_L(0); PG8_MMA(1, 0, At, B0); PG8_BAR; PG8_SCHED;
            PG8_STAGE(PG8_SB(1, 1), b3 + hstep, voffB);
            PG8_WAIT_V(6); PG8_BAR; PG8_MMA(1, 1, At, B1); PG8_BAR;
            }
        }
        if constexpr (Sched::DYNAMIC) { static_assert(!Sched::DYNAMIC || ALIGN_EPI, "dynamic orders publish in front of the ALIGN_EPI barrier"); S.claim_publish(ui + 2, pend, wid, lane); }
        if constexpr (ALIGN_EPI) { if (wr == 0) PG8_BAR; }
        if constexpr (!Epi::AFTER_DRAIN) { E(acc, cur, wr, wc, fr, fq); S.done(cur); }
        if (!has_next) break;
#pragma unroll
        for (int a = 0; a < 2; ++a)
#pragma unroll
            for (int b = 0; b < 2; ++b)
#pragma unroll
                for (int m = 0; m < 4; ++m)
#pragma unroll
                    for (int n = 0; n < 2; ++n) acc[a][b][m][n] = (f32x4){0.f, 0.f, 0.f, 0.f};
        cur = nxt; cA = nA; cB = nB; ++ui;
        if constexpr (ALIGN_EPI) { if (wr == 1) PG8_BAR; }
    }
    PG8_WAIT_V(0);
    if constexpr (!ALIGN_EPI) { if (wr == 0) PG8_BAR; }
    PG8_BAR;
    if constexpr (Epi::AFTER_DRAIN) { E.fused(acc, cur, wr, wc, fr, fq, lds, wid, lane); S.done(cur); }
#undef PG8_SA
#undef PG8_SB
#undef PG8_STAGE
#undef PG8_LDA
#undef PG8_LDB
#undef PG8_MMA
#undef PG8_WAIT_V
#undef PG8_WAIT_L
#undef PG8_BAR
#undef PG8_SCHED
}

template <class Epi, class Sched>
__device__ __forceinline__ void gemm_phase_gather(PG8_LAS unsigned char* lds, const Gemm g, const int* __restrict__ gidx, PG8_LAS int* itab  , const Sched& S, const Epi& E) {
    const int tid = threadIdx.x, wid = __builtin_amdgcn_readfirstlane(tid >> 6), lane = tid & 63, wr = wid >> 2, wc = wid & 3, fr = lane & 15, fq = lane >> 4;
    const int K = g.K, nt = K / BK;
    int RA[2], CA[2]; unsigned voffB[2];
#pragma unroll
    for (int i = 0; i < 2; ++i) { int R, C; stage_rc(tid * 16 + i * 8192, R, C); const int Rb = Epi::PERM ? ((R & ~31) + perm32(R & 31)) : R;
        RA[i] = R; CA[i] = C; voffB[i] = (unsigned)(Rb * K + C) * 2u; }
    const size_t kstep = (size_t)(BK * 2);
    const size_t hstep = (size_t)HALF * K * 2;
    const size_t tstep = 2 * hstep;
    const unsigned ldsw = (unsigned)wid * 1024u;
    const int aoff = lds_byte(wr * 64 + fr, fq * 8), boff = lds_byte(wc * 32 + fr, fq * 8);
#define PG8_SA(b, h) (((b) * 2 + (h)) * HTB)
#define PG8_SB(b, h) ((4 + (b) * 2 + (h)) * HTB)
#define PG8_STAGE(bufoff, gbase, voff) do { _Pragma("unroll") for (int _i = 0; _i < 2; ++_i) \
        __builtin_amdgcn_global_load_lds((const unsigned*)((const char*)(gbase) + (voff)[_i]), (PG8_LAS unsigned*)(lds + (bufoff) + ldsw + _i * 8192), 16, 0, 0); } while (0)
#define PG8_LDA(dst, b, h) do { _Pragma("unroll") for (int m = 0; m < 4; ++m) _Pragma("unroll") for (int k = 0; k < 2; ++k) dst[m][k] = *(const PG8_LAS bf16x8*)(lds + PG8_SA(b, h) + aoff + m * 2048 + k * 1024); } while (0)
#define PG8_LDB(dst, b, h) do { _Pragma("unroll") for (int n = 0; n < 2; ++n) _Pragma("unroll") for (int k = 0; k < 2; ++k) dst[n][k] = *(const PG8_LAS bf16x8*)(lds + PG8_SB(b, h) + boff + n * 2048 + k * 1024); } while (0)
#define PG8_MMA(ai, bj, At, Bt) do { __builtin_amdgcn_s_setprio(1); _Pragma("unroll") for (int m = 0; m < 4; ++m) _Pragma("unroll") for (int n = 0; n < 2; ++n) _Pragma("unroll") for (int k = 0; k < 2; ++k) \
        acc[ai][bj][m][n] = __builtin_amdgcn_mfma_f32_16x16x32_bf16(Bt[n][k], At[m][k], acc[ai][bj][m][n], 0, 0, 0); __builtin_amdgcn_s_setprio(0); } while (0)
#define PG8_WAIT_V(n) asm volatile("s_waitcnt vmcnt(" #n ")" ::: "memory")
#define PG8_WAIT_L(n) asm volatile("s_waitcnt lgkmcnt(" #n ")" ::: "memory")
#define PG8_BAR __builtin_amdgcn_s_barrier()
#define PG8_SCHED __builtin_amdgcn_sched_barrier(0)
#define PG8_GOFF(dst, ord) do { _Pragma("unroll") for (int _h = 0; _h < 2; ++_h) _Pragma("unroll") for (int _i = 0; _i < 2; ++_i) \
        dst[_h][_i] = ((unsigned)itab[(ord) * BM + _h * HALF + RA[_i]] * (unsigned)K + (unsigned)CA[_i]) * 2u; } while (0)
    { int vals[4];
#pragma unroll
      for (int k = 0; k < 4; ++k) { const int e = tid + 512 * k; Unit uu; const bool ok = S.next(e >> 8, uu); vals[k] = ok ? gidx[uu.pm * BM + (e & 255)] : 0; }
#pragma unroll
      for (int k = 0; k < 4; ++k) itab[tid + 512 * k] = vals[k];
      asm volatile("s_waitcnt vmcnt(0) lgkmcnt(0)" ::: "memory"); __builtin_amdgcn_s_barrier(); asm volatile("" ::: "memory"); }
    Unit cur, nxt; int ui = 0;
    if (!S.next(0, cur)) return;
    f32x4 acc[2][2][4][2];
#pragma unroll
    for (int a = 0; a < 2; ++a)
#pragma unroll
        for (int b = 0; b < 2; ++b)
#pragma unroll
            for (int m = 0; m < 4; ++m)
#pragma unroll
                for (int n = 0; n < 2; ++n) acc[a][b][m][n] = (f32x4){0.f, 0.f, 0.f, 0.f};
    bf16x8 At[4][2], B0[2][2], B1[2][2];
    const char* const gA = (const char*)g.A;
    unsigned cvo[2][2], nvo[2][2];
    PG8_GOFF(cvo, 0);
    const char* cB = (const char*)g.Bt + (size_t)cur.pn * tstep;
    S.a_ready(cur);
    PG8_STAGE(PG8_SB(0, 0), cB, voffB); PG8_STAGE(PG8_SB(0, 1), cB + hstep, voffB); PG8_STAGE(PG8_SA(0, 0), gA, cvo[0]); PG8_STAGE(PG8_SA(0, 1), gA, cvo[1]);
    if (wr == 1) PG8_BAR;
    PG8_WAIT_V(2); PG8_BAR;
    PG8_STAGE(PG8_SB(1, 0), cB + kstep, voffB); PG8_STAGE(PG8_SA(1, 0), gA + kstep, cvo[0]); PG8_STAGE(PG8_SB(1, 1), cB + hstep + kstep, voffB);
    PG8_WAIT_V(6); PG8_BAR;
    for (;;) {
        const bool has_next = S.next(ui + 1, nxt);
        if (has_next) { PG8_GOFF(nvo, ui + 1); } else {
#pragma unroll
            for (int _h = 0; _h < 2; ++_h)
#pragma unroll
                for (int _i = 0; _i < 2; ++_i) nvo[_h][_i] = cvo[_h][_i]; }
        const char* nB = has_next ? (const char*)g.Bt + (size_t)nxt.pn * tstep : cB;
        for (int t = 0; t < nt; t += 2) {
            const bool last = (t == nt - 2);
            const char* a1 = gA + (size_t)(t + 1) * kstep;
            const char* a2 = last ? gA : gA + (size_t)(t + 2) * kstep; const char* b2 = last ? nB : cB + (size_t)(t + 2) * kstep;
            const char* a3 = a2 + kstep; const char* b3 = b2 + kstep;
            unsigned vo2[2][2];
#pragma unroll
            for (int _h = 0; _h < 2; ++_h)
#pragma unroll
                for (int _i = 0; _i < 2; ++_i) vo2[_h][_i] = last ? nvo[_h][_i] : cvo[_h][_i];
            if (last && has_next) S.a_ready(nxt);
            PG8_LDB(B0, 0, 0); PG8_LDB(B1, 0, 1); PG8_SCHED; PG8_LDA(At, 0, 0); PG8_STAGE(PG8_SA(1, 1), a1, cvo[1]);
            PG8_WAIT_V(8); PG8_WAIT_L(0); PG8_BAR; PG8_MMA(0, 0, At, B0); PG8_MMA(0, 1, At, B1); PG8_BAR; PG8_SCHED;
            PG8_LDA(At, 0, 1); PG8_STAGE(PG8_SB(0, 0), b2, voffB); PG8_STAGE(PG8_SB(0, 1), b2 + hstep, voffB); PG8_STAGE(PG8_SA(0, 0), a2, vo2[0]);
            PG8_WAIT_V(8); PG8_WAIT_L(0); PG8_BAR; PG8_MMA(1, 0, At, B0); PG8_MMA(1, 1, At, B1); PG8_BAR; PG8_SCHED;
            PG8_LDB(B0, 1, 0); PG8_LDB(B1, 1, 1); PG8_SCHED; PG8_LDA(At, 1, 0); PG8_STAGE(PG8_SA(0, 1), a2, vo2[1]);
            PG8_WAIT_V(8); PG8_WAIT_L(0); PG8_BAR; PG8_MMA(0, 0, At, B0); PG8_MMA(0, 1, At, B1); PG8_BAR; PG8_SCHED;
            PG8_LDA(At, 1, 1); PG8_STAGE(PG8_SB(1, 0), b3, voffB); PG8_STAGE(PG8_SB(1, 1), b3 + hstep, voffB); PG8_STAGE(PG8_SA(1, 0), a3, vo2[0]);
            PG8_WAIT_V(8); PG8_WAIT_L(0); PG8_BAR; PG8_MMA(1, 0, At, B0); PG8_MMA(1, 1, At, B1); PG8_BAR; PG8_SCHED;
        }
        if (wr == 0) PG8_BAR;
        E(acc, cur, wr, wc, fr, fq); S.done(cur);
        if (!has_next) break;
#pragma unroll
        for (int a = 0; a < 2; ++a)
#pragma unroll
            for (int b = 0; b < 2; ++b)
#pragma unroll
                for (int m = 0; m < 4; ++m)
#pragma unroll
                    for (int n = 0; n < 2; ++n) acc[a][b][m][n] = (f32x4){0.f, 0.f, 0.f, 0.f};
        cur = nxt; cB = nB; ++ui;
#pragma unroll
        for (int _h = 0; _h < 2; ++_h)
#pragma unroll
            for (int _i = 0; _i < 2; ++_i) cvo[_h][_i] = nvo[_h][_i];
        if (wr == 1) PG8_BAR;
    }
    PG8_WAIT_V(0);
    PG8_BAR;
#undef PG8_GOFF
#undef PG8_SA
#undef PG8_SB
#undef PG8_STAGE
#undef PG8_LDA
#undef PG8_LDB
#undef PG8_MMA
#undef PG8_WAIT_V
#undef PG8_WAIT_L
#undef PG8_BAR
#undef PG8_SCHED
}
}

constexpr int NB = 4, SEQ = 4096, D = 2048, CTXL = 256;
constexpr int M = NB * SEQ;
constexpr int MC = NB * CTXL;
constexpr int MT = M + MC;
constexpr int NHEAD = 32, HD = 64, NGRP = 4, NST = 128;
constexpr int XBCW = 3072;
constexpr int PROJ_COLS = 15424;
constexpr int NPROJ_TILES = 61;
constexpr int NPROJ = NPROJ_TILES * 256;
constexpr int NE = 16, FF = 2048, CAP = 512;
constexpr int MODW = 6 * D;
constexpr float EPS = 1e-6f;

#ifndef MK_N_LAUNCHES
#define MK_N_LAUNCHES 1
#endif
constexpr int NPHASES = 13;
constexpr int NCHUNK = MT / 128;
constexpr int XTCH = 2560;

constexpr size_t MiB = 1u << 20;
constexpr size_t WS_CTL = 0, CTL_ZERO_BYTES = 1 * MiB;
constexpr size_t WS_MODX = 1 * MiB;
constexpr size_t WS_MODC = WS_MODX + 256 * 1024;
constexpr size_t WS_AFF = 2 * MiB;
constexpr size_t WS_SLOT = 3 * MiB;
constexpr size_t WS_IDX = 4 * MiB;
constexpr size_t WS_VAL = 4 * MiB + 512 * 1024;
constexpr size_t WS_DTS = 11 * MiB;
constexpr size_t WS_WSSD = 16 * MiB, WS_WSC = 24 * MiB, WS_WO = 32 * MiB;
constexpr size_t WS_G = 40 * MiB;
constexpr size_t WS_ACT = 40 * MiB;
constexpr size_t WS_SCY = 168 * MiB;
constexpr size_t WS_Z = 232 * MiB;
constexpr size_t WS_HX2 = WS_Z;
constexpr size_t WS_XBC = 296 * MiB;
constexpr size_t WS_MERGED = 296 * MiB;
constexpr size_t WS_OUTE = 296 * MiB;
constexpr size_t WS_XBCR = 392 * MiB;
constexpr size_t WS_HX = 398 * MiB;
constexpr size_t WS_WIN = 466 * MiB;
constexpr size_t WS_HENT = 398 * MiB;
constexpr size_t WS_OUTX = 398 * MiB;
constexpr size_t WS_ST = 527 * MiB;
constexpr size_t WS_Y = 527 * MiB;
constexpr size_t WS_CHLOG = 5 * MiB;
constexpr size_t WS_W13 = 663 * MiB;
constexpr size_t WS_W2 = 919 * MiB;
constexpr size_t WS_END = 1047 * MiB;
constexpr int CW_BAR = 4096;
constexpr int CW_Q0 = 64, CW_Q1 = 128, CW_Q2 = 192, CW_Q3 = 256, CW_QG = 512  ;

constexpr int RING_BYTES = 131072;
constexpr int LDSCTL_OFF = 162816, MISC_OFF = LDSCTL_OFF + 320;
constexpr int LDS_BYTES = 163840;
constexpr int NWAVES = 8;

#define GAS __attribute__((address_space(1)))
#define LAS __attribute__((address_space(3)))
typedef unsigned short bf16;
typedef unsigned v4u __attribute__((ext_vector_type(4)));
typedef unsigned v2u __attribute__((ext_vector_type(2)));
typedef float f32x4 __attribute__((ext_vector_type(4)));
typedef float f32x16 __attribute__((ext_vector_type(16)));
typedef short bf16x8 __attribute__((ext_vector_type(8)));
#define LDS_WAIT() asm volatile("s_waitcnt lgkmcnt(0)" ::: "memory")
#define VM_WAIT() asm volatile("s_waitcnt vmcnt(0)" ::: "memory")
__device__ __forceinline__ unsigned pk2(float lo, float hi) { typedef float f2v __attribute__((ext_vector_type(2))); typedef __bf16 b2v __attribute__((ext_vector_type(2))); const f2v v = {lo, hi}; return __builtin_bit_cast(unsigned, __builtin_convertvector(v, b2v)); }
__device__ __forceinline__ float bflo(unsigned w) { return __builtin_bit_cast(float, w << 16); }
__device__ __forceinline__ float bfhi(unsigned w) { return __builtin_bit_cast(float, w & 0xffff0000u); }
__device__ __forceinline__ void unpack8(const v4u w, float (&o)[8]) { o[0] = bflo(w.x); o[1] = bfhi(w.x); o[2] = bflo(w.y); o[3] = bfhi(w.y); o[4] = bflo(w.z); o[5] = bfhi(w.z); o[6] = bflo(w.w); o[7] = bfhi(w.w); }
__device__ __forceinline__ v4u pack8(const float (&o)[8]) { v4u w; w.x = pk2(o[0], o[1]); w.y = pk2(o[2], o[3]); w.z = pk2(o[4], o[5]); w.w = pk2(o[6], o[7]); return w; }
__device__ __forceinline__ float siluf(float x) { return x * __builtin_amdgcn_rcpf(1.f + __expf(-x)); }
__device__ __forceinline__ float sigmf(float x) { return __builtin_amdgcn_rcpf(1.f + __expf(-x)); }
__device__ __forceinline__ float wave_sum(float v) {
#pragma unroll
    for (int o = 1; o < 64; o <<= 1) v += __shfl_xor(v, o);
    return v;
}

#define XB_TMO      128
#define XB_XCNT(j)  (256  + 64 * (j))
#define XB_XSUB(j)  (1280 + 64 * (j))
#define XB_XGEN(j)  (2304 + 64 * (j))
#define XB_TOP      3328
#define XB_TOPGEN   3392
#define XCD_BAR_WORDS 3456
#define XB_SPIN_CAP (1u << 18)

__device__ __forceinline__ unsigned xb_ld(unsigned* p)              { return __hip_atomic_load(p, __ATOMIC_RELAXED, __HIP_MEMORY_SCOPE_AGENT); }
__device__ __forceinline__ unsigned xb_add(unsigned* p, unsigned v) { return __hip_atomic_fetch_add(p, v, __ATOMIC_RELAXED, __HIP_MEMORY_SCOPE_AGENT); }
__device__ __forceinline__ unsigned xb_xcc_id() { return (unsigned)__builtin_amdgcn_s_getreg((3 << 11) | 20) & 0xFu; }
#define XB_SPIN(cond, bar) do { unsigned _sp = 0; while (cond) { __builtin_amdgcn_s_sleep(1); \
    if ((++_sp & 255u) == 0u) { if (xb_ld(&(bar)[XB_TMO])) break; if (_sp > XB_SPIN_CAP) { atomicAdd(&(bar)[XB_TMO], 1u); break; } } } } while (0)

struct XcdBarrier {
    unsigned* bar; unsigned x;
    volatile LAS unsigned* st;
};
__device__ __forceinline__ XcdBarrier xcd_barrier_post(unsigned* bar, volatile LAS unsigned* st) {
    XcdBarrier b; b.bar = bar; b.x = xb_xcc_id(); b.st = st;
    if (threadIdx.x == 0) (void)xb_add(&bar[XB_XCNT(b.x)], 1u);
    return b;
}
__device__ __forceinline__ void xcd_barrier_complete(unsigned* bar, unsigned x, unsigned& nloc, unsigned& nx) {
    const unsigned G = gridDim.x * gridDim.y * gridDim.z;
    unsigned sum, cnt, mine, sp = 0u;
    for (;;) {
        sum = 0u; cnt = 0u; mine = 0u;
#pragma unroll
        for (unsigned j = 0; j < 16; ++j) { const unsigned c = xb_ld(&bar[XB_XCNT(j)]); sum += c; cnt += (c > 0u) ? 1u : 0u; mine = (j == x) ? c : mine; }
        if (sum == G) break;
        __builtin_amdgcn_s_sleep(1);
        if ((++sp & 255u) == 0u) { if (xb_ld(&bar[XB_TMO])) break; if (sp > XB_SPIN_CAP) { atomicAdd(&bar[XB_TMO], 1u); break; } }
    }
    nloc = mine > 0u ? mine : 1u; nx = cnt > 0u ? cnt : 1u;
}
__device__ __forceinline__ void xcd_barrier(const XcdBarrier& b) {
    asm volatile("s_waitcnt vmcnt(0)" ::: "memory");
    __syncthreads();
    if (threadIdx.x == 0) {
        unsigned* bar = b.bar;
        __builtin_amdgcn_s_waitcnt(0);
        unsigned nloc = b.st[0], nx = b.st[1];
        if (nloc == 0u) { xcd_barrier_complete(bar, b.x, nloc, nx); b.st[0] = nloc; b.st[1] = nx; }
        const unsigned old = xb_add(&bar[XB_XSUB(b.x)], 1u);
        const unsigned gen = old / nloc;
        if (old + 1u == (gen + 1u) * nloc) {
            __builtin_amdgcn_fence(__ATOMIC_RELEASE, "agent");
            asm volatile("s_waitcnt vmcnt(0)" ::: "memory");
            const unsigned og = xb_add(&bar[XB_TOP], 1u);
            const unsigned tg = og / nx;
            if (og + 1u == (tg + 1u) * nx) xb_add(&bar[XB_TOPGEN], 1u);
            else XB_SPIN(xb_ld(&bar[XB_TOPGEN]) == tg, bar);
            __builtin_amdgcn_fence(__ATOMIC_ACQUIRE, "agent");
            xb_add(&bar[XB_XGEN(b.x)], 1u);
            asm volatile("s_waitcnt vmcnt(0)" ::: "memory");
        } else {
            XB_SPIN(xb_ld(&bar[XB_XGEN(b.x)]) == gen, bar);
            __builtin_amdgcn_fence(__ATOMIC_ACQUIRE, "agent");
            asm volatile("s_waitcnt vmcnt(0)" ::: "memory");
        }
    }
    __syncthreads();
}

struct WTile { const float* src; bf16* dst; const float* ksc; int ldw, ldk, perm; };
#define WTILE_STORE(T, v) do { \
    if ((T).ksc) { _Pragma("unroll") for (int j = 0; j < 16; ++j) v[j] = v[j] * (T).ksc[16 * kq + j]; } \
    const int drow_ = (T).perm ? 32 * (n4 >> 2) + 8 * (n4 & 3) : 4 * n4; \
    _Pragma("unroll") for (int q = 0; q < 4; ++q) { bf16* d = (T).dst + (size_t)(drow_ + q) * (T).ldk + 16 * kq; \
        v4u w0, w1; w0.x = pk2(v[0][q], v[1][q]); w0.y = pk2(v[2][q], v[3][q]); w0.z = pk2(v[4][q], v[5][q]); w0.w = pk2(v[6][q], v[7][q]); \
        w1.x = pk2(v[8][q], v[9][q]); w1.y = pk2(v[10][q], v[11][q]); w1.z = pk2(v[12][q], v[13][q]); w1.w = pk2(v[14][q], v[15][q]); \
        *(v4u*)d = w0; *(v4u*)(d + 8) = w1; } } while (0)
__device__ __forceinline__ void wtile_copy_pair(const WTile A, const WTile B, int lane) {
    const int n4 = lane & 15, kq = lane >> 4;
    f32x4 va[16], vb[16];
    { const float* s = A.src + (size_t)(16 * kq) * A.ldw + 4 * n4;
#pragma unroll
      for (int j = 0; j < 16; ++j) va[j] = __builtin_nontemporal_load((const f32x4*)(s + (size_t)j * A.ldw)); }
    { const float* s = B.src + (size_t)(16 * kq) * B.ldw + 4 * n4;
#pragma unroll
      for (int j = 0; j < 16; ++j) vb[j] = __builtin_nontemporal_load((const f32x4*)(s + (size_t)j * B.ldw)); }
    WTILE_STORE(A, va); WTILE_STORE(B, vb);
}
struct ExpertCopy { const float* w_e1; const float* w_e3; const float* w_e2; bf16* W13; bf16* W2; };
__device__ __forceinline__ WTile expert_tile_addr(const ExpertCopy& X, int it) {
    constexpr int I_SQ = 32 * 32;
    const int e = it / (3 * I_SQ); int r = it % (3 * I_SQ); const int which = r / I_SQ; r %= I_SQ; const int kb = r / 32, nb = r % 32, n0 = nb * 64, k0 = kb * 64;
    WTile t; t.ksc = nullptr; t.perm = 0;
    if (which == 0) { t.src = X.w_e1 + (size_t)e * D * FF + (size_t)k0 * FF + n0; t.ldw = FF; t.dst = X.W13 + (size_t)(e * 4096 + 256 * (n0 / 128) + (n0 % 128)) * D + k0; t.ldk = D; }
    else if (which == 1) { t.src = X.w_e3 + (size_t)e * D * FF + (size_t)k0 * FF + n0; t.ldw = FF; t.dst = X.W13 + (size_t)(e * 4096 + 256 * (n0 / 128) + 128 + (n0 % 128)) * D + k0; t.ldk = D; }
    else { t.src = X.w_e2 + (size_t)e * FF * D + (size_t)k0 * D + n0; t.ldw = D; t.dst = X.W2 + (size_t)(e * 2048 + n0) * FF + k0; t.ldk = FF; }
    return t;
}
#define WTILE_LOAD(T, v) do { const float* s_ = (T).src + (size_t)(16 * kq) * (T).ldw + 4 * n4; \
    _Pragma("unroll") for (int j = 0; j < 16; ++j) v[j] = __builtin_nontemporal_load((const f32x4*)(s_ + (size_t)j * (T).ldw)); } while (0)
__device__ __forceinline__ void expert_copy_share(const ExpertCopy& X, unsigned* qhead, int lane) {
    constexpr int NIT = NE * 3 * 32 * 32, GRP = 16;
    static_assert(FF == D && NIT % GRP == 0 && 32 % GRP == 0, "group addressing");
    const int n4 = lane & 15, kq = lane >> 4;
#pragma unroll 1
    for (;;) { int g0 = 0; if (lane == 0) g0 = (int)__hip_atomic_fetch_add(qhead, (unsigned)GRP, __ATOMIC_RELAXED, __HIP_MEMORY_SCOPE_AGENT);
        g0 = __builtin_amdgcn_readfirstlane(g0); if (g0 >= NIT) break;
        const WTile t0 = expert_tile_addr(X, g0); const bool w13 = (g0 / (32 * 32)) % 3 != 2;
        f32x4 va[16], vb[16];
        WTile ta = t0, tb = t0; tb.src = t0.src + 64; tb.dst = t0.dst + (size_t)64 * D;
        WTILE_LOAD(ta, va); WTILE_LOAD(tb, vb);
#pragma unroll
        for (int k = 0; k < GRP; k += 2) {
            __builtin_amdgcn_sched_barrier(0);
            WTILE_STORE(ta, va);
            if (k + 2 < GRP) { ta.src = t0.src + 64 * (k + 2); ta.dst = t0.dst + (size_t)(w13 ? 256 * ((k + 2) >> 1) : 64 * (k + 2)) * D; WTILE_LOAD(ta, va); }
            __builtin_amdgcn_sched_barrier(0);
            WTILE_STORE(tb, vb);
            if (k + 3 < GRP) { tb.src = t0.src + 64 * (k + 3); tb.dst = t0.dst + (size_t)(w13 ? 256 * ((k + 3) >> 1) + 64 : 64 * (k + 3)) * D; WTILE_LOAD(tb, vb); }
        }
    }
}
struct MixerCopy { const float* w_in; const float* w_ssd_out; const float* w_sc_out; const float* w_o; const float* ssd_norm_w; bf16* WIN; bf16* WSSD; bf16* WSC; bf16* WO; };
__device__ __forceinline__ WTile mixer_tile_addr(const MixerCopy& X, int it) {
    constexpr int I_IN = 32 * (PROJ_COLS / 64), I_SQ = 32 * 32;
    WTile t; t.ksc = nullptr; t.perm = 0;
    if (it < I_IN) { const int kb = it / (PROJ_COLS / 64), nb = it % (PROJ_COLS / 64), n0 = nb * 64, k0 = kb * 64; int vrow;
        if (n0 < 2048) { vrow = (12 + n0 / 64) * 256 + 128 + 4; t.perm = 1; }
        else if (n0 < 5120) vrow = n0 - 2048;
        else if (n0 < 5184) vrow = 60 * 256 + (n0 - 5120);
        else if (n0 < 7232) { vrow = (12 + (n0 - 5184) / 64) * 256; t.perm = 1; }
        else if (n0 < 9280) { vrow = (12 + (n0 - 7232) / 64) * 256 + 4; t.perm = 1; }
        else if (n0 < 11328) { vrow = (12 + (n0 - 9280) / 64) * 256 + 128; t.perm = 1; }
        else vrow = 44 * 256 + (n0 - 11328);
        t.src = X.w_in + (size_t)k0 * PROJ_COLS + n0; t.ldw = PROJ_COLS; t.dst = X.WIN + (size_t)vrow * D + k0; t.ldk = D; return t; }
    int r = it - I_IN; const int which = r / I_SQ; r %= I_SQ; const int kb = r / 32, nb = r % 32, n0 = nb * 64, k0 = kb * 64;
    const size_t so = (size_t)k0 * D + n0, dof = (size_t)n0 * D + k0; t.ldw = D; t.ldk = D;
    if (which == 0) { t.src = X.w_ssd_out + so; t.dst = X.WSSD + dof; t.ksc = X.ssd_norm_w + k0; }
    else if (which == 1) { t.src = X.w_sc_out + so; t.dst = X.WSC + dof; }
    else { t.src = X.w_o + so; t.dst = X.WO + dof; }
    return t;
}
struct OrderProj {
    static constexpr bool DYNAMIC = false;
    pg8::StaticOrder so; int G, c;
    __device__ __forceinline__ void init(int G_, int c_) { G = G_; c = c_; so.init(M, NPROJ, G_, c_); }
    __device__ __forceinline__ bool next(int i, pg8::Unit& u) const {
        const int L = i * G + c;
        if (L < 64 * NPROJ_TILES) return so.next(i, u);
        const int j = L - 64 * NPROJ_TILES; if (j >= 4 * 13) return false;
        u.pm = 64 + j / 13; const int k = j % 13; u.pn = k < 12 ? k : 60; return true;
    }
    __device__ __forceinline__ void a_ready(const pg8::Unit&) const {}
    __device__ __forceinline__ void done(const pg8::Unit&) const {}
};
struct OrderProjDyn {
    static constexpr bool DYNAMIC = true;
    unsigned* q; volatile LAS unsigned* slot; int x;
    __device__ __forceinline__ void init(unsigned* q0, volatile LAS unsigned* slot_, int c) { x = c & 7; q = q0 + 64 * x; slot = slot_;
        __syncthreads();
        if (threadIdx.x == 0) { const unsigned k = __hip_atomic_fetch_add(q, 2u, __ATOMIC_RELAXED, __HIP_MEMORY_SCOPE_AGENT); slot[0] = k; slot[1] = k + 1u; }
        __syncthreads(); }
    __device__ __forceinline__ bool next(int i, pg8::Unit& u) const {
        constexpr int QX = 64 * NPROJ_TILES / 8;
        const int k = __builtin_amdgcn_readfirstlane((int)slot[i & 3]);
        if (k < QX) { u.pm = 8 * x + (k & 7); u.pn = k >> 3; return true; }
        const int j = (k - QX) * 8 + x; if (j >= 4 * 13) return false;
        u.pm = 64 + j / 13; const int kk = j % 13; u.pn = kk < 12 ? kk : 60; return true;
    }
    __device__ __forceinline__ unsigned claim_issue(int wid, int lane) const { unsigned r = 0u; if (wid == 0 && lane == 0) { unsigned z; asm volatile("v_mov_b32 %0, 0" : "=v"(z)); r = __hip_atomic_fetch_add(q + z, 1u, __ATOMIC_RELAXED, __HIP_MEMORY_SCOPE_AGENT); } return r; }
    __device__ __forceinline__ void claim_publish(int i, unsigned r, int wid, int lane) const { const unsigned rr = __builtin_amdgcn_readfirstlane(r); if (lane == 0) slot[wid == 0 ? (i & 3) : 4 + wid] = rr; asm volatile("s_waitcnt lgkmcnt(0)" ::: "memory"); }
    __device__ __forceinline__ void a_ready(const pg8::Unit&) const {}
    __device__ __forceinline__ void done(const pg8::Unit&) const {}
};
template <int NJ> struct OrderMoe {
    static constexpr bool DYNAMIC = false;
    int G, c;
    __device__ __forceinline__ void init(int G_, int c_) { G = G_; c = c_; }
    __device__ __forceinline__ bool next(int i, pg8::Unit& u) const {
        constexpr int NWG = NE * 8 * NJ, Q = NWG / 8;
        const int L = i * G + c; if (L >= NWG) return false;
        const int wgid = (L % 8) * Q + L / 8;
        const int e = wgid / (8 * NJ), w = wgid % (8 * NJ), rt = w % 8, j = w / 8, b = rt >> 1, half = rt & 1;
        u.pm = (b * NE + e) * 2 + half; u.pn = e * NJ + j; return true;
    }
    __device__ __forceinline__ void a_ready(const pg8::Unit&) const {}
    __device__ __forceinline__ void done(const pg8::Unit&) const {}
};

struct OrderTwice {
    static constexpr bool DYNAMIC = false;
    pg8::StaticOrder so; int R;
    __device__ __forceinline__ bool next(int i, pg8::Unit& u) const { const int s = i >= R ? 1 : 0; const bool ok = so.next(i - s * R, u); u.sel = s; return ok && i < 2 * R; }
    __device__ __forceinline__ void a_ready(const pg8::Unit&) const {}
    __device__ __forceinline__ void done(const pg8::Unit&) const {}
};
using pg8::f32x4;
using pg8::u32x4;
__device__ __forceinline__ float softplusf(float x) { return x > 20.f ? x : log1pf(expf(x)); }
__device__ __forceinline__ float dpp_ror1(float v) { return __builtin_bit_cast(float, __builtin_amdgcn_update_dpp(0, __builtin_bit_cast(int, v), 0x121, 0xf, 0xf, false)); }
__device__ __forceinline__ float dpp_ror15(float v) { return __builtin_bit_cast(float, __builtin_amdgcn_update_dpp(0, __builtin_bit_cast(int, v), 0x12F, 0xf, 0xf, false)); }
struct EpiProj {
    static constexpr bool PERM = true, AFTER_DRAIN = false;
    bf16 *Z, *XBC, *XBCR, *SCY, *Gt; float* DTS; const float *cw, *cb, *scw, *dtb;
    __device__ __forceinline__ void operator()(const f32x4 (&acc)[2][2][4][2], const pg8::Unit& u, int wr, int wc, int fr, int fq_in) const {
        int fq = fq_in; asm volatile("" : "+v"(fq));
        const int row0 = u.pm * 256 + wr * 64 + fr; const int pn = u.pn;
        if (pn < 12) {
            const int col0 = pn * 256 + wc * 32 + 8 * fq;
            if (u.pm >= 64) {
#pragma unroll
                for (int ai = 0; ai < 2; ++ai)
#pragma unroll
                    for (int m = 0; m < 4; ++m) { bf16* rowp = XBCR + (size_t)(row0 - M + ai * 128 + m * 16) * XBCW + col0;
#pragma unroll
                        for (int bj = 0; bj < 2; ++bj) { const f32x4 v0 = acc[ai][bj][m][0], v1 = acc[ai][bj][m][1];
                            u32x4 w; w.x = pg8::cvt_pk_bf16(v0[0], v0[1]); w.y = pg8::cvt_pk_bf16(v0[2], v0[3]); w.z = pg8::cvt_pk_bf16(v1[0], v1[1]); w.w = pg8::cvt_pk_bf16(v1[2], v1[3]);
                            *(u32x4*)(rowp + bj * 128) = w; } }
            } else {
#pragma unroll
                for (int bj = 0; bj < 2; ++bj) {
                    const int col = col0 + bj * 128;
                    f32x4 w0[2], w1[2], w2[2], bb[2];
#pragma unroll
                    for (int n = 0; n < 2; ++n) { w0[n] = *(const f32x4*)(cw + col + 4 * n); w1[n] = *(const f32x4*)(cw + XBCW + col + 4 * n); w2[n] = *(const f32x4*)(cw + 2 * XBCW + col + 4 * n); bb[n] = *(const f32x4*)(cb + col + 4 * n); }
#pragma unroll
                    for (int ai = 0; ai < 2; ++ai) {
                        f32x4 o[4][2];
#pragma unroll
                        for (int n = 0; n < 2; ++n)
#pragma unroll
                            for (int q = 0; q < 4; ++q) { float A[4], B[4];
#pragma unroll
                                for (int m = 0; m < 4; ++m) { A[m] = dpp_ror1(acc[ai][bj][m][n][q]); B[m] = dpp_ror15(acc[ai][bj][m][n][q]); }
#pragma unroll
                                for (int m = 0; m < 4; ++m) { const float pv = fr > 0 ? A[m] : (m > 0 ? A[m > 0 ? m - 1 : 0] : 0.f), nv = fr < 15 ? B[m] : (m < 3 ? B[m < 3 ? m + 1 : 3] : 0.f);
                                    o[m][n][q] = siluf(bb[n][q] + w0[n][q] * pv + w1[n][q] * acc[ai][bj][m][n][q] + w2[n][q] * nv); } }
#pragma unroll
                        for (int m = 0; m < 4; ++m) { u32x4 w; w.x = pg8::cvt_pk_bf16(o[m][0][0], o[m][0][1]); w.y = pg8::cvt_pk_bf16(o[m][0][2], o[m][0][3]); w.z = pg8::cvt_pk_bf16(o[m][1][0], o[m][1][1]); w.w = pg8::cvt_pk_bf16(o[m][1][2], o[m][1][3]);
                            *(u32x4*)(XBC + (size_t)(row0 + ai * 128 + m * 16) * XBCW + col) = w; }
                    }
                }
            }
        } else if (pn < 44) {
            const int ch = (pn - 12) * 64 + wc * 16 + 4 * fq;
            const f32x4 w0 = *(const f32x4*)(scw + ch), w1 = *(const f32x4*)(scw + D + ch), w2 = *(const f32x4*)(scw + 2 * D + ch);
#pragma unroll
            for (int ai = 0; ai < 2; ++ai) {
                f32x4 cv[4];
#pragma unroll
                for (int m = 0; m < 4; ++m) cv[m] = acc[ai][0][m][1] * acc[ai][1][m][0];
                f32x4 o[4];
#pragma unroll
                for (int q = 0; q < 4; ++q) { float A[4], B[4];
#pragma unroll
                    for (int m = 0; m < 4; ++m) { A[m] = dpp_ror1(cv[m][q]); B[m] = dpp_ror15(cv[m][q]); }
#pragma unroll
                    for (int m = 0; m < 4; ++m) { const float pv = fr > 0 ? A[m] : (m > 0 ? A[m > 0 ? m - 1 : 0] : 0.f), nv = fr < 15 ? B[m] : (m < 3 ? B[m < 3 ? m + 1 : 3] : 0.f);
                        o[m][q] = acc[ai][0][m][0][q] * (w0[q] * pv + w1[q] * cv[m][q] + w2[q] * nv); } }
#pragma unroll
                for (int m = 0; m < 4; ++m) { const size_t row = (size_t)(row0 + ai * 128 + m * 16); const f32x4 zz = acc[ai][1][m][1];
                    v2u ws_; ws_.x = pg8::cvt_pk_bf16(o[m][0], o[m][1]); ws_.y = pg8::cvt_pk_bf16(o[m][2], o[m][3]); *(v2u*)(SCY + row * D + ch) = ws_;
                    v2u wz; wz.x = pg8::cvt_pk_bf16(zz[0], zz[1]); wz.y = pg8::cvt_pk_bf16(zz[2], zz[3]); *(v2u*)(Z + row * D + ch) = wz; }
            }
        } else if (pn < 60) {
            const int col0 = (pn - 44) * 256 + wc * 32 + 8 * fq;
#pragma unroll
            for (int ai = 0; ai < 2; ++ai)
#pragma unroll
                for (int m = 0; m < 4; ++m) { bf16* rowp = Gt + (size_t)(row0 + ai * 128 + m * 16) * (2 * D) + col0;
#pragma unroll
                    for (int bj = 0; bj < 2; ++bj) { const f32x4 v0 = acc[ai][bj][m][0], v1 = acc[ai][bj][m][1];
                        u32x4 w; w.x = pg8::cvt_pk_bf16(v0[0], v0[1]); w.y = pg8::cvt_pk_bf16(v0[2], v0[3]); w.z = pg8::cvt_pk_bf16(v1[0], v1[1]); w.w = pg8::cvt_pk_bf16(v1[2], v1[3]);
                        *(u32x4*)(rowp + bj * 128) = w; } }
        } else {
            if (wc < 2) {
                const int col0 = wc * 32 + 8 * fq; const f32x4 b0 = *(const f32x4*)(dtb + col0), b1 = *(const f32x4*)(dtb + col0 + 4);
#pragma unroll
                for (int ai = 0; ai < 2; ++ai)
#pragma unroll
                    for (int m = 0; m < 4; ++m) { float* rowp = DTS + (size_t)(row0 + ai * 128 + m * 16) * 64 + col0; f32x4 o0, o1;
#pragma unroll
                        for (int q = 0; q < 4; ++q) { o0[q] = softplusf(acc[ai][0][m][0][q] + b0[q]); o1[q] = softplusf(acc[ai][0][m][1][q] + b1[q]); }
                        *(f32x4*)(rowp) = o0; *(f32x4*)(rowp + 4) = o1; }
            }
        }
    }
};
struct EpiBf16Plain {
    static constexpr bool PERM = true, AFTER_DRAIN = false;
    bf16* O; int ldc;
    __device__ __forceinline__ void operator()(const f32x4 (&acc)[2][2][4][2], const pg8::Unit& u, int wr, int wc, int fr, int fq) const {
        const int row0 = u.pm * 256 + wr * 64 + fr, col0 = u.pn * 256 + wc * 32 + 8 * fq;
#pragma unroll
        for (int ai = 0; ai < 2; ++ai)
#pragma unroll
            for (int m = 0; m < 4; ++m) { bf16* rowp = O + (size_t)(row0 + ai * 128 + m * 16) * ldc + col0;
#pragma unroll
                for (int bj = 0; bj < 2; ++bj) { const f32x4 v0 = acc[ai][bj][m][0], v1 = acc[ai][bj][m][1];
                    u32x4 w; w.x = pg8::cvt_pk_bf16(v0[0], v0[1]); w.y = pg8::cvt_pk_bf16(v0[2], v0[3]); w.z = pg8::cvt_pk_bf16(v1[0], v1[1]); w.w = pg8::cvt_pk_bf16(v1[2], v1[3]);
                    *(u32x4*)(rowp + bj * 128) = w; } }
    }
};
struct EpiGate {
    static constexpr bool PERM = true, AFTER_DRAIN = false;
    const bf16* Gt; const float* bg; bf16* O;
    __device__ __forceinline__ void operator()(const f32x4 (&acc)[2][2][4][2], const pg8::Unit& u, int wr, int wc, int fr, int fq_in) const {
        int fq = fq_in; asm volatile("" : "+v"(fq));
        const int row0 = u.pm * 256 + wr * 64 + fr, col0 = u.pn * 256 + wc * 32 + 8 * fq; const bool first = u.sel == 0; const int goff = first ? 0 : D;
#pragma unroll
        for (int bj = 0; bj < 2; ++bj) {
            const int col = col0 + bj * 128;
            float b0[8];
            { const f32x4 t0 = *(const f32x4*)(bg + goff + col), t1 = *(const f32x4*)(bg + goff + col + 4);
#pragma unroll
              for (int q = 0; q < 4; ++q) { b0[q] = t0[q]; b0[4 + q] = t1[q]; } }
#pragma unroll
            for (int ai = 0; ai < 2; ++ai) {
                v4u gw_[4], pw_[4];
#pragma unroll
                for (int m = 0; m < 4; ++m) { const size_t row = (size_t)(row0 + ai * 128 + m * 16);
                    gw_[m] = *(const v4u*)(Gt + row * (2 * D) + goff + col); pw_[m] = first ? (v4u){0u, 0u, 0u, 0u} : *(const v4u*)(O + row * D + col); }
                __builtin_amdgcn_sched_barrier(0);
#pragma unroll
                for (int m = 0; m < 4; ++m) { const size_t row = (size_t)(row0 + ai * 128 + m * 16);
                    float g0[8], p[8]; unpack8(gw_[m], g0); unpack8(pw_[m], p);
                    float o[8];
#pragma unroll
                    for (int q = 0; q < 4; ++q) { o[q] = p[q] + sigmf(g0[q] + b0[q]) * acc[ai][bj][m][0][q]; o[4 + q] = p[4 + q] + sigmf(g0[4 + q] + b0[4 + q]) * acc[ai][bj][m][1][q]; }
                    *(v4u*)(O + row * D + col) = pack8(o); }
            }
        }
    }
};
struct EpiMoe1 {
    static constexpr bool PERM = true, AFTER_DRAIN = false;
    bf16* ACT;
    __device__ __forceinline__ void operator()(const f32x4 (&acc)[2][2][4][2], const pg8::Unit& u, int wr, int wc, int fr, int fq) const {
        const int row0 = u.pm * 256 + wr * 64 + fr, col0 = (u.pn & 15) * 128 + wc * 32 + 8 * fq;
#pragma unroll
        for (int ai = 0; ai < 2; ++ai)
#pragma unroll
            for (int m = 0; m < 4; ++m) { float o[8];
#pragma unroll
                for (int q = 0; q < 4; ++q) { o[q] = siluf(acc[ai][0][m][0][q]) * acc[ai][1][m][0][q]; o[4 + q] = siluf(acc[ai][0][m][1][q]) * acc[ai][1][m][1][q]; }
                *(v4u*)(ACT + (size_t)(row0 + ai * 128 + m * 16) * FF + col0) = pack8(o); }
    }
};
struct EpiMoe2 {
    static constexpr bool PERM = true, AFTER_DRAIN = false;
    bf16* O; const float* VAL;
    __device__ __forceinline__ void operator()(const f32x4 (&acc)[2][2][4][2], const pg8::Unit& u, int wr, int wc, int fr, int fq) const {
        const int row0 = u.pm * 256 + wr * 64 + fr, col0 = (u.pn & 7) * 256 + wc * 32 + 8 * fq;
        float sv[2][4];
#pragma unroll
        for (int ai = 0; ai < 2; ++ai)
#pragma unroll
            for (int m = 0; m < 4; ++m) sv[ai][m] = VAL[row0 + ai * 128 + m * 16];
#pragma unroll
        for (int ai = 0; ai < 2; ++ai)
#pragma unroll
            for (int m = 0; m < 4; ++m) { const int row = row0 + ai * 128 + m * 16; const float s = sv[ai][m]; bf16* rowp = O + (size_t)row * D + col0;
#pragma unroll
                for (int bj = 0; bj < 2; ++bj) { const f32x4 v0 = acc[ai][bj][m][0] * s, v1 = acc[ai][bj][m][1] * s;
                    v4u w; w.x = pk2(v0[0], v0[1]); w.y = pk2(v0[2], v0[3]); w.z = pk2(v1[0], v1[1]); w.w = pk2(v1[2], v1[3]);
                    *(v4u*)(rowp + bj * 128) = w; } }
    }
};

__device__ __forceinline__ v4u conv8r(const v4u cur, const v4u prv, const v4u nxt, const float* __restrict__ cw, const float* __restrict__ cb, int ch) {
    float c[8], p[8], n[8], o[8]; unpack8(cur, c); unpack8(prv, p); unpack8(nxt, n);
#pragma unroll
    for (int h4 = 0; h4 < 2; ++h4) { const f32x4 w0 = *(const f32x4*)(cw + ch + 4 * h4), w1 = *(const f32x4*)(cw + XBCW + ch + 4 * h4), w2 = *(const f32x4*)(cw + 2 * XBCW + ch + 4 * h4), bb = *(const f32x4*)(cb + ch + 4 * h4);
#pragma unroll
        for (int q = 0; q < 4; ++q) o[4 * h4 + q] = siluf(bb[q] + w0[q] * p[4 * h4 + q] + w1[q] * c[4 * h4 + q] + w2[q] * n[4 * h4 + q]); }
    return pack8(o);
}
__device__ __forceinline__ v4u conv8c(const bf16* __restrict__ XBCR, const float* __restrict__ cw, const float* __restrict__ cb, int rc, int ch) {
    const int pos = rc & 255; const bool hp = pos > 0, hn = pos < 255;
    const bf16* p = XBCR + (size_t)rc * XBCW + ch;
    const v4u cur = *(const v4u*)p; v4u prv = *(const v4u*)(hp ? p - XBCW : p), nxt = *(const v4u*)(hn ? p + XBCW : p);
    prv.x = hp ? prv.x : 0u; prv.y = hp ? prv.y : 0u; prv.z = hp ? prv.z : 0u; prv.w = hp ? prv.w : 0u;
    nxt.x = hn ? nxt.x : 0u; nxt.y = hn ? nxt.y : 0u; nxt.z = hn ? nxt.z : 0u; nxt.w = hn ? nxt.w : 0u;
    return conv8r(cur, prv, nxt, cw, cb, ch);
}
typedef short v4i16_t __attribute__((ext_vector_type(4)));
__device__ __forceinline__ v2u tr_read(const LAS unsigned char* p) { return __builtin_bit_cast(v2u, __builtin_amdgcn_ds_read_tr16_b64_v4i16((LAS v4i16_t*)p)); }

__device__ __forceinline__ int claim_item(unsigned* qhead, volatile LAS unsigned* slot) {
    __syncthreads();
    if (threadIdx.x == 0) *slot = __hip_atomic_fetch_add(qhead, 1u, __ATOMIC_RELAXED, __HIP_MEMORY_SCOPE_AGENT);
    __syncthreads();
    return (int)*slot;
}
struct Args { const float* in[26]; float* out; unsigned char* ws; int ph_lo, ph_hi; };
static_assert(sizeof(Args) == 26 * 8 + 8 + 8 + 8, "Args has no padding");

__global__ void __launch_bounds__(NWAVES * 64, 2) mk_fwd(Args args) {
    extern __shared__ __attribute__((aligned(16))) unsigned char lds_raw[];
    LAS unsigned char* lds = (LAS unsigned char*)lds_raw;
    volatile LAS unsigned* MISC = (volatile LAS unsigned*)(lds + MISC_OFF);
    const int tid = threadIdx.x, lane = tid & 63, wave = __builtin_amdgcn_readfirstlane(tid >> 6);
    const int G = gridDim.x, bx = blockIdx.x;
    const int gw = bx * NWAVES + wave, NGW = G * NWAVES;
    const size_t gtid = (size_t)bx * (NWAVES * 64) + tid, NGT = (size_t)G * (NWAVES * 64);
    unsigned* ctl = (unsigned*)(args.ws + WS_CTL);

#define KAS __attribute__((address_space(4)))
#define PHASE_BASES() const KAS char* KA = (const KAS char*)__builtin_amdgcn_kernarg_segment_ptr(); asm volatile("" : "+s"(KA)); unsigned char* const ws = *(unsigned char* const KAS*)(KA + 8 * 27)
#define KARG(k) (*(const float* const KAS*)(KA + 8 * (k)))
#define in_x KARG(0)
#define cvec KARG(1)
#define ctx KARG(2)
#define c_ctx KARG(3)
#define w_mod KARG(4)
#define b_mod KARG(5)
#define n_pre_mix KARG(6)
#define n_post_mix KARG(7)
#define w_in KARG(8)
#define ssd_conv_w KARG(9)
#define ssd_conv_b KARG(10)
#define dt_bias KARG(11)
#define a_log KARG(12)
#define ssd_d KARG(13)
#define ssd_norm_w KARG(14)
#define w_ssd_out KARG(15)
#define sc_conv_w KARG(16)
#define w_sc_out KARG(17)
#define b_gate KARG(18)
#define w_o KARG(19)
#define n_pre_ffn KARG(20)
#define n_post_ffn KARG(21)
#define w_router KARG(22)
#define w_e1 KARG(23)
#define w_e3 KARG(24)
#define w_e2 KARG(25)
#define out (*(float* const KAS*)(KA + 8 * 26))
#define MODX ((float*)(ws + WS_MODX))
#define MODC ((float*)(ws + WS_MODC))
#define AFF ((float*)(ws + WS_AFF))
#define SLOT ((int*)(ws + WS_SLOT))
#define IDX ((int*)(ws + WS_IDX))
#define VAL ((float*)(ws + WS_VAL))
#define DTS ((float*)(ws + WS_DTS))
#define WIN ((bf16*)(ws + WS_WIN))
#define WSSD ((bf16*)(ws + WS_WSSD))
#define WSC ((bf16*)(ws + WS_WSC))
#define WO ((bf16*)(ws + WS_WO))
#define HX ((bf16*)(ws + WS_HX))
#define Zb ((bf16*)(ws + WS_Z))
#define XBC ((bf16*)(ws + WS_XBC))
#define XBCR ((bf16*)(ws + WS_XBCR))
#define Gt ((bf16*)(ws + WS_G))
#define SCY ((bf16*)(ws + WS_SCY))
#define ST ((bf16*)(ws + WS_ST))
#define HENT ((bf16*)(ws + WS_HENT))
#define CHLOG ((float*)(ws + WS_CHLOG))
#define Yn ((bf16*)(ws + WS_Y))
#define MERGED ((bf16*)(ws + WS_MERGED))
#define OUTX ((bf16*)(ws + WS_OUTX))
#define HX2 ((bf16*)(ws + WS_HX2))
#define W13 ((bf16*)(ws + WS_W13))
#define W2 ((bf16*)(ws + WS_W2))
#define ACT ((bf16*)(ws + WS_ACT))
#define OUTE ((bf16*)(ws + WS_OUTE))
    for (int u = tid; u < (LDS_BYTES - LDSCTL_OFF) / 4; u += NWAVES * 64) ((LAS unsigned*)(lds + LDSCTL_OFF))[u] = 0u;
    __syncthreads();
    XcdBarrier bar; bar.bar = ctl + CW_BAR; bar.x = 0; bar.st = nullptr;
    if (MK_N_LAUNCHES == 1) bar = xcd_barrier_post(ctl + CW_BAR, MISC + 8);
#define GRID_BAR() do { if (MK_N_LAUNCHES == 1) xcd_barrier(bar); } while (0)
    const int lo = args.ph_lo, hi = args.ph_hi;
#ifndef PH_MASK
#define PH_MASK 0xFFFFFFFFu
#endif
#define IN(k) (((PH_MASK >> (k)) & 1u) && lo <= (k) && (k) < hi)
#define BOTH(k) (IN(k) && IN((k) + 1))

    if (IN(0)) { PHASE_BASES();
        for (int bi = bx; bi < MODW / 128; bi += G) {
            LAS float* sl = (LAS float*)lds;
            LAS float* red = (LAS float*)(lds + 5 * 2048 * 4);
            for (int i = tid; i < 5 * D; i += NWAVES * 64) { const int r = i / D, k = i % D; const float v = r < 4 ? cvec[r * D + k] : c_ctx[k]; sl[i] = siluf(v); }
            __syncthreads();
            const int c4 = lane & 31, kh = lane >> 5;
            f32x4 a0 = {0.f, 0.f, 0.f, 0.f}, a1 = a0, a2 = a0, a3 = a0, a4 = a0;
            const float* wp = w_mod + (size_t)(wave * 256 + kh) * MODW + bi * 128 + 4 * c4;
#pragma unroll 8
            for (int kk = 0; kk < 128; ++kk) { const f32x4 wv = *(const f32x4*)(wp + (size_t)(2 * kk) * MODW); const int k = wave * 256 + 2 * kk + kh;
                a0 += wv * sl[k]; a1 += wv * sl[D + k]; a2 += wv * sl[2 * D + k]; a3 += wv * sl[3 * D + k]; a4 += wv * sl[4 * D + k]; }
#pragma unroll
            for (int q = 0; q < 4; ++q) { a0[q] += __shfl_xor(a0[q], 32); a1[q] += __shfl_xor(a1[q], 32); a2[q] += __shfl_xor(a2[q], 32); a3[q] += __shfl_xor(a3[q], 32); a4[q] += __shfl_xor(a4[q], 32); }
            if (kh == 0) { *(LAS f32x4*)(red + (wave * 5 + 0) * 128 + 4 * c4) = a0; *(LAS f32x4*)(red + (wave * 5 + 1) * 128 + 4 * c4) = a1; *(LAS f32x4*)(red + (wave * 5 + 2) * 128 + 4 * c4) = a2;
                           *(LAS f32x4*)(red + (wave * 5 + 3) * 128 + 4 * c4) = a3; *(LAS f32x4*)(red + (wave * 5 + 4) * 128 + 4 * c4) = a4; }
            __syncthreads();
            for (int i = tid; i < 5 * 128; i += NWAVES * 64) { const int r = i >> 7, l = i & 127; float sacc = 0.f;
#pragma unroll
                for (int w = 0; w < 8; ++w) sacc += red[(w * 5 + r) * 128 + l];
                const int cc = bi * 128 + l; sacc += b_mod[cc]; if (r < 4) MODX[r * MODW + cc] = sacc; else MODC[cc] = sacc; }
            __syncthreads();
        }
        { constexpr int NIT = 32 * (PROJ_COLS / 64) + 3 * 32 * 32;
          const MixerCopy X{w_in, w_ssd_out, w_sc_out, w_o, ssd_norm_w, WIN, WSSD, WSC, WO};
#pragma unroll 1
          for (;;) { int g0 = 0; if (lane == 0) g0 = (int)__hip_atomic_fetch_add(ctl + CW_Q0, 8u, __ATOMIC_RELAXED, __HIP_MEMORY_SCOPE_AGENT);
              g0 = __builtin_amdgcn_readfirstlane(g0); if (g0 >= NIT) break;
#pragma unroll 1
              for (int k = 0; k < 8; k += 2) wtile_copy_pair(mixer_tile_addr(X, g0 + k), mixer_tile_addr(X, g0 + k + 1), lane); } }
        { v4u* zp = (v4u*)(WIN + (size_t)15424 * D); const size_t nz = (size_t)192 * D * 2 / 16; for (size_t i = gtid; i < nz; i += NGT) zp[i] = (v4u){0u, 0u, 0u, 0u}; }
        if (BOTH(0)) GRID_BAR();
    }

    if (IN(1)) { PHASE_BASES();
        for (int row = gw; row < MT; row += NGW) {
            const float* src; const float* sh; const float* sc;
            if (row < M) { const int b = row / SEQ; src = in_x + (size_t)row * D; sh = MODX + b * MODW; sc = sh + D; }
            else { src = ctx + (size_t)(row - M) * D; sh = MODC; sc = MODC + D; }
            f32x4 v[8], pg[8], ps1[8], ps0[8]; float ss = 0.f;
#pragma unroll
            for (int j = 0; j < 8; ++j) v[j] = __builtin_nontemporal_load((const f32x4*)src + lane + 64 * j);
#pragma unroll
            for (int j = 0; j < 8; ++j) { pg[j] = ((const f32x4*)n_pre_mix)[lane + 64 * j]; ps1[j] = ((const f32x4*)sc)[lane + 64 * j]; ps0[j] = ((const f32x4*)sh)[lane + 64 * j]; }
#pragma unroll
            for (int j = 0; j < 8; ++j) ss += (v[j].x * v[j].x + v[j].y * v[j].y) + (v[j].z * v[j].z + v[j].w * v[j].w);
            const float rstd = 1.0f / sqrtf(wave_sum(ss) * (1.f / D) + EPS);
            v2u* o8 = (v2u*)(HX + (size_t)row * D) + lane;
#pragma unroll
            for (int j = 0; j < 8; ++j) { const f32x4 o = (v[j] * rstd * pg[j]) * (ps1[j] + 1.0f) + ps0[j]; v2u w; w.x = pk2(o.x, o.y); w.y = pk2(o.z, o.w); o8[64 * j] = w; }
        }
        if (BOTH(1)) GRID_BAR();
    }

    if (IN(2)) { PHASE_BASES();
        if (((bx >> 3) & 3) == 0) { const ExpertCopy X{w_e1, w_e3, w_e2, W13, W2}; expert_copy_share(X, ctl + CW_Q1, lane); }
        pg8::Gemm g{HX, WIN, MT, NPROJ, D}; OrderProjDyn S; S.init(ctl + CW_QG, MISC + 24, bx);
        EpiProj E{Zb, XBC, XBCR, SCY, Gt, DTS, ssd_conv_w, ssd_conv_b, sc_conv_w, dt_bias};
        pg8::gemm_phase<EpiProj, OrderProjDyn, true, true>(lds, g, S, E);
        if (BOTH(2)) GRID_BAR();
    }

    if (IN(3)) { PHASE_BASES();
        LAS unsigned char* sBt = lds;
        LAS unsigned char* sXt = lds + 40960;
        LAS float* sW = (LAS float*)(lds + 40960 + 73728) + wave * 128;
        const int r32 = lane & 31, hh = lane >> 5, hl = wave >> 1, dir = wave & 1;
        const int li = lane & 15, tq = li >> 2, tp = li & 3, blk = (lane >> 4) & 1;
        for (int item = claim_item(ctl + CW_Q2, MISC + 16); item < NCHUNK * 8; item = claim_item(ctl + CW_Q2, MISC + 16)) {
            const int cg = item >> 3, grp = (item >> 1) & 3, hq = item & 1, head = grp * 8 + hq * 4 + hl, row0 = cg * 128;
            __syncthreads();
            int t1 = tid; asm volatile("" : "+v"(t1));
            if (cg < 128) {
#pragma unroll
                for (int m = 0; m < 4; ++m) { const int q = t1 + 512 * m, tok = q >> 4, ck = q & 15;
                    *(LAS v4u*)(sBt + tok * 320 + ck * 16) = *(const v4u*)(XBC + (size_t)(row0 + tok) * XBCW + 2048 + grp * 128 + ck * 8); }
#pragma unroll
                for (int m = 0; m < 8; ++m) { const int q = t1 + 512 * m, tok = q >> 5, ck = q & 31;
                    *(LAS v4u*)(sXt + tok * 576 + ck * 16) = *(const v4u*)(XBC + (size_t)(row0 + tok) * XBCW + grp * 512 + hq * 256 + ck * 8); }
            } else {
#pragma unroll 2
                for (int m = 0; m < 4; ++m) { const int q = t1 + 512 * m, tok = q >> 4, ck = q & 15;
                    *(LAS v4u*)(sBt + tok * 320 + ck * 16) = conv8c(XBCR, ssd_conv_w, ssd_conv_b, row0 - M + tok, 2048 + grp * 128 + ck * 8); }
#pragma unroll 2
                for (int m = 0; m < 8; ++m) { const int q = t1 + 512 * m, tok = q >> 5, ck = q & 31;
                    *(LAS v4u*)(sXt + tok * 576 + ck * 16) = conv8c(XBCR, ssd_conv_w, ssd_conv_b, row0 - M + tok, grp * 512 + hq * 256 + ck * 8); }
            }
            { int ln = t1 & 63;
              const float d0 = DTS[(size_t)(row0 + 2 * ln) * 64 + dir * 32 + head], d1 = DTS[(size_t)(row0 + 2 * ln + 1) * 64 + dir * 32 + head];
              const float a = -expf(a_log[dir * 32 + head]); const float v0 = a * d0, v1 = a * d1;
              float inc = v0 + v1;
#pragma unroll
              for (int o = 1; o < 64; o <<= 1) { const float t = __shfl_up(inc, o); if (ln >= o) inc += t; }
              const float tot = __shfl(inc, 63), ex = inc - (v0 + v1);
              const float w0 = dir ? expf(ex) * d0 : expf(tot - (ex + v0)) * d0, w1 = dir ? expf(ex + v0) * d1 : expf(tot - (ex + v0 + v1)) * d1;
              sW[2 * ln] = w0; sW[2 * ln + 1] = w1;
              if (ln == 0) CHLOG[(cg * 2 + dir) * 32 + head] = tot; }
            __syncthreads();
            f32x16 acc[4][2];
#pragma unroll
            for (int nt = 0; nt < 4; ++nt)
#pragma unroll
                for (int pt = 0; pt < 2; ++pt)
#pragma unroll
                    for (int k = 0; k < 16; ++k) acc[nt][pt][k] = 0.f;
            const LAS unsigned char* xrd = sXt + (8 * hh + tq) * 576 + (hl * 64 + 16 * blk + 4 * tp) * 2;
            const LAS unsigned char* brd = sBt + (8 * hh + tq) * 320 + (16 * blk + 4 * tp) * 2;
#pragma unroll 2
            for (int s = 0; s < 8; ++s) {
                const f32x4 w0 = *(const LAS f32x4*)(sW + 16 * s + 8 * hh), w1 = *(const LAS f32x4*)(sW + 16 * s + 8 * hh + 4);
                bf16x8 xf[2];
#pragma unroll
                for (int pt = 0; pt < 2; ++pt) { const v2u lo = tr_read(xrd + (16 * s) * 576 + 64 * pt), hi = tr_read(xrd + (16 * s + 4) * 576 + 64 * pt);
                    float t[8] = {bflo(lo.x) * w0[0], bfhi(lo.x) * w0[1], bflo(lo.y) * w0[2], bfhi(lo.y) * w0[3], bflo(hi.x) * w1[0], bfhi(hi.x) * w1[1], bflo(hi.y) * w1[2], bfhi(hi.y) * w1[3]};
                    xf[pt] = __builtin_bit_cast(bf16x8, pack8(t)); }
#pragma unroll
                for (int nt = 0; nt < 4; ++nt) { const v2u lo = tr_read(brd + (16 * s) * 320 + 64 * nt), hi = tr_read(brd + (16 * s + 4) * 320 + 64 * nt);
                    v4u bw; bw.x = lo.x; bw.y = lo.y; bw.z = hi.x; bw.w = hi.y; const bf16x8 bfm = __builtin_bit_cast(bf16x8, bw);
#pragma unroll
                    for (int pt = 0; pt < 2; ++pt) acc[nt][pt] = __builtin_amdgcn_mfma_f32_32x32x16_bf16(bfm, xf[pt], acc[nt][pt], 0, 0, 0); }
            }
            __syncthreads();
            { LAS unsigned char* sS = lds + wave * 16896;
#pragma unroll
              for (int nt = 0; nt < 4; ++nt)
#pragma unroll
                  for (int pt = 0; pt < 2; ++pt)
#pragma unroll
                      for (int gq = 0; gq < 4; ++gq) { v2u w; w.x = pk2(acc[nt][pt][4 * gq], acc[nt][pt][4 * gq + 1]); w.y = pk2(acc[nt][pt][4 * gq + 2], acc[nt][pt][4 * gq + 3]);
                          *(LAS v2u*)(sS + (32 * pt + r32) * 264 + (32 * nt + 8 * gq + 4 * hh) * 2) = w; }
              LDS_WAIT(); asm volatile("" ::: "memory");
              bf16* stp = ST + ((size_t)(cg * 2 + dir) * 32 + head) * 8192;
#pragma unroll
              for (int k = 0; k < 16; ++k) { const int p = 4 * k + (lane >> 4), c16 = lane & 15;
                  const LAS unsigned char* src = sS + p * 264 + c16 * 16; v4u v; v.x = *(const LAS unsigned*)src; v.y = *(const LAS unsigned*)(src + 4); v.z = *(const LAS unsigned*)(src + 8); v.w = *(const LAS unsigned*)(src + 12);
                  *(v4u*)(stp + p * 128 + c16 * 8) = v; } }
        }
        __syncthreads();
        if (BOTH(3)) GRID_BAR();
    }

    if (IN(4)) { PHASE_BASES();
        for (int item = bx; item < NB * NHEAD * 2; item += G) {
            const int b = item >> 6, head = (item >> 1) & 31, dir = item & 1;
            float h[16];
#pragma unroll
            for (int k = 0; k < 16; ++k) h[k] = 0.f;
#pragma unroll 2
            for (int step = 0; step < 34; ++step) {
                const int cg = dir == 0 ? (step < 2 ? 128 + 2 * b + step : 32 * b + (step - 2)) : (step < 2 ? 128 + 2 * b + 1 - step : 32 * b + 31 - (step - 2));
                const size_t base = ((size_t)(cg * 2 + dir) * 32 + head) * 8192;
                const float dec = expf(CHLOG[(cg * 2 + dir) * 32 + head]);
                float s0[8], s1[8]; unpack8(__builtin_nontemporal_load((const v4u*)(ST + base + tid * 8)), s0); unpack8(__builtin_nontemporal_load((const v4u*)(ST + base + 4096 + tid * 8)), s1);
                if (step >= 2) { float t0[8], t1[8];
#pragma unroll
                    for (int k = 0; k < 8; ++k) { t0[k] = h[k]; t1[k] = h[8 + k]; }
                    *(v4u*)(HENT + base + tid * 8) = pack8(t0); *(v4u*)(HENT + base + 4096 + tid * 8) = pack8(t1); }
#pragma unroll
                for (int k = 0; k < 8; ++k) { h[k] = dec * h[k] + s0[k]; h[8 + k] = dec * h[8 + k] + s1[k]; }
            }
        }
        if (BOTH(4)) GRID_BAR();
    }

    if (IN(5)) { PHASE_BASES();
        LAS unsigned char* sBt = lds;
        LAS unsigned char* sCz = lds + 34816;
        LAS unsigned char* sHF = lds + 69632;
        LAS unsigned char* sHB = lds + 87040;
        LAS unsigned char* sX = lds + 104448;
        LAS float* sTab0 = (LAS float*)(lds + 129024);
        LAS float* SSQ = (LAS float*)(lds + 137216);
        LAS unsigned char* sY = lds + 138240;
        const int r32 = lane & 31, hh = lane >> 5, it = wave & 3, pt = wave >> 2, i = 32 * it + r32;
        const int li = lane & 15, tq = li >> 2, tp = li & 3, blk = (lane >> 4) & 1;
        for (int item = claim_item(ctl + CW_Q3, MISC + 17); item < 128 * 4; item = claim_item(ctl + CW_Q3, MISC + 17)) {
            const int cg = item >> 2, grp = item & 3, row0 = cg * 128;
            __syncthreads();
            int t1 = tid; asm volatile("" : "+v"(t1));
#pragma unroll
            for (int m = 0; m < 4; ++m) { const int q = t1 + 512 * m, tok = q >> 4, ck = q & 15;
                *(LAS v4u*)(sBt + tok * 272 + ck * 16) = *(const v4u*)(XBC + (size_t)(row0 + tok) * XBCW + 2048 + grp * 128 + ck * 8);
                *(LAS v4u*)(sCz + tok * 272 + ck * 16) = *(const v4u*)(XBC + (size_t)(row0 + tok) * XBCW + 2560 + grp * 128 + ck * 8); }
            { const int head = grp * 8;
#pragma unroll
              for (int m = 0; m < 4; ++m) { const int q = t1 + 512 * m, which = q >> 10, r = (q & 1023) >> 4, ck = q & 15;
                  *(LAS v4u*)(sHF + which * 17408 + r * 272 + ck * 16) = __builtin_nontemporal_load((const v4u*)(HENT + ((size_t)(cg * 2 + which) * 32 + head) * 8192 + r * 128 + ck * 8)); }
#pragma unroll
              for (int m = 0; m < 2; ++m) { const int q = t1 + 512 * m, tok = q >> 3, ck = q & 7;
                  *(LAS v4u*)(sX + tok * 192 + ck * 16) = *(const v4u*)(XBC + (size_t)(row0 + tok) * XBCW + head * 64 + ck * 8); } }
            float tAF0, tAF1, tAB0, tAB1, tDF0, tDF1, tDB0, tDB1;
            { const int head = grp * 8 + wave; int ln = t1 & 63;
              const float dF0 = DTS[(size_t)(row0 + 2 * ln) * 64 + head], dF1 = DTS[(size_t)(row0 + 2 * ln + 1) * 64 + head];
              const float dB0 = DTS[(size_t)(row0 + 2 * ln) * 64 + 32 + head], dB1 = DTS[(size_t)(row0 + 2 * ln + 1) * 64 + 32 + head];
              const float aF = -expf(a_log[head]), aB = -expf(a_log[32 + head]);
              const float vF0 = aF * dF0, vF1 = aF * dF1, vB0 = aB * dB0, vB1 = aB * dB1;
              float inF = vF0 + vF1, inB = vB0 + vB1;
#pragma unroll
              for (int o = 1; o < 64; o <<= 1) { const float tF = __shfl_up(inF, o), tB = __shfl_up(inB, o); if (ln >= o) { inF += tF; inB += tB; } }
              const float totB = __shfl(inB, 63);
              const float exF = inF - (vF0 + vF1), exB = inB - (vB0 + vB1);
              tAF0 = exF + vF0; tAF1 = exF + vF0 + vF1;
              tAB0 = totB - exB; tAB1 = totB - (exB + vB0);
              tDF0 = dF0; tDF1 = dF1; tDB0 = dB0; tDB1 = dB1; }
#define P6_WRITE_TABLES(hdx) do { int ln = (int)(threadIdx.x & 63u); asm volatile("" : "+v"(ln)); LAS float* sTab = sTab0 + ((hdx) & 1) * 1024; LAS float* sArr = sTab + 512; \
            sArr[2 * ln] = tAF0; sArr[2 * ln + 1] = tAF1; sArr[128 + 2 * ln] = tAB0; sArr[128 + 2 * ln + 1] = tAB1; \
            sArr[256 + 2 * ln] = tDF0; sArr[256 + 2 * ln + 1] = tDF1; sArr[384 + 2 * ln] = tDB0; sArr[384 + 2 * ln + 1] = tDB1; \
            _Pragma("unroll") for (int tt = 0; tt < 4; ++tt) { const float refF = __shfl(tAF0, 16 * tt), refB = __shfl(tAB1, 16 * tt + 15); const int j0 = 2 * ln; \
                sTab[tt * 128 + j0]     = j0 < 32 * tt     ? __expf(refF - tAF0) * tDF0 : (j0 >= 32 * tt + 32     ? __expf(refB - tAB0) * tDB0 : 0.f); \
                sTab[tt * 128 + j0 + 1] = j0 + 1 < 32 * tt ? __expf(refF - tAF1) * tDF1 : (j0 + 1 >= 32 * tt + 32 ? __expf(refB - tAB1) * tDB1 : 0.f); } } while (0)
            if (wave == 0) P6_WRITE_TABLES(0);
            __syncthreads();
            bf16x8 cf[8];
#pragma unroll
            for (int s = 0; s < 8; ++s) cf[s] = *(const LAS bf16x8*)(sCz + i * 272 + 32 * s + 16 * hh);
            __syncthreads();
            { const int head = grp * 8;
#pragma unroll
              for (int m = 0; m < 2; ++m) { const int q = t1 + 512 * m, tok = q >> 3, ck = q & 7;
                  *(LAS v4u*)(sCz + tok * 192 + ck * 16) = *(const v4u*)(Zb + (size_t)(row0 + tok) * D + head * 64 + ck * 8); } }
            __syncthreads();
            float ssq_acc = 0.f;
#pragma unroll 1
            for (int hd = 0; hd < 8; ++hd) {
                const int head = grp * 8 + hd;
                int t2 = tid; asm volatile("" : "+v"(t2));
                int iv = r32; asm volatile("" : "+v"(iv));
                if (wave == hd + 1) P6_WRITE_TABLES(hd + 1);
                const LAS float* sTab = sTab0 + (hd & 1) * 1024; const LAS float* sArr = sTab + 512;
                v4u pfh[4], pfz[2], pxc[2];
                if (hd < 7) {
#pragma unroll
                    for (int m = 0; m < 4; ++m) { const int q = t2 + 512 * m, which = q >> 10, r = (q & 1023) >> 4, ck = q & 15;
                        pfh[m] = __builtin_nontemporal_load((const v4u*)(HENT + ((size_t)(cg * 2 + which) * 32 + head + 1) * 8192 + r * 128 + ck * 8)); }
#pragma unroll
                    for (int m = 0; m < 2; ++m) { const int q = t2 + 512 * m, tok = q >> 3, ck = q & 7; const size_t r = (size_t)(row0 + tok);
                        pfz[m] = __builtin_nontemporal_load((const v4u*)(Zb + r * D + (head + 1) * 64 + ck * 8)); pxc[m] = __builtin_nontemporal_load((const v4u*)(XBC + r * XBCW + (head + 1) * 64 + ck * 8)); } }
                __builtin_amdgcn_sched_barrier(0);
                const LAS unsigned char* pHF = sHF + (32 * pt + r32) * 272 + 16 * hh; asm volatile("" : "+v"(pHF));
                const LAS unsigned char* pHB = sHB + (32 * pt + r32) * 272 + 16 * hh; asm volatile("" : "+v"(pHB));
                const LAS unsigned char* pBt = sBt + r32 * 272 + 16 * hh; asm volatile("" : "+v"(pBt));
                const LAS float* pTab = sTab + it * 128 + 4 * hh; asm volatile("" : "+v"(pTab));
                const LAS float* pArr = sArr + 4 * hh; asm volatile("" : "+v"(pArr));
                const LAS float* pArrI = sArr + i; asm volatile("" : "+v"(pArrI));
                const LAS float* pArrT = sArr + 32 * it; asm volatile("" : "+v"(pArrT));
                const LAS unsigned char* pXi = sX + i * 192 + 64 * pt + 8 * hh; asm volatile("" : "+v"(pXi));
                const LAS unsigned char* pZi = sCz + i * 192 + 64 * pt + 8 * hh; asm volatile("" : "+v"(pZi));
                const float aFi = pArrI[0], aBi = pArrI[128];
                const float eF = expf(aFi), eB = expf(aBi), rowF = __expf(aFi - pArrT[0]), rowB = __expf(aBi - pArrT[128 + 31]);
                f32x16 acc, tL;
#pragma unroll
                for (int k = 0; k < 16; ++k) { acc[k] = 0.f; tL[k] = 0.f; }
#pragma unroll
                for (int s = 0; s < 8; ++s) {
                    acc = __builtin_amdgcn_mfma_f32_32x32x16_bf16(*(const LAS bf16x8*)(pHF + 32 * s), cf[s], acc, 0, 0, 0);
                    tL = __builtin_amdgcn_mfma_f32_32x32x16_bf16(*(const LAS bf16x8*)(pHB + 32 * s), cf[s], tL, 0, 0, 0); }
#pragma unroll
                for (int k = 0; k < 16; ++k) { acc[k] = acc[k] * eF + tL[k] * eB; tL[k] = 0.f; }
                const LAS unsigned char* xrd = sX + (4 * hh + tq) * 192 + (32 * pt + 16 * blk + 4 * tp) * 2; asm volatile("" : "+v"(xrd));
#pragma unroll
                for (int jt = 0; jt < 4; ++jt) {
                    __builtin_amdgcn_sched_barrier(0);
                    f32x16 Xf;
#pragma unroll
                    for (int k = 0; k < 16; ++k) Xf[k] = 0.f;
#pragma unroll
                    for (int s = 0; s < 8; ++s) Xf = __builtin_amdgcn_mfma_f32_32x32x16_bf16(*(const LAS bf16x8*)(pBt + (32 * jt) * 272 + 32 * s), cf[s], Xf, 0, 0, 0);
                    if (jt != it) {
#pragma unroll
                        for (int gq = 0; gq < 4; ++gq) { const f32x4 T = *(const LAS f32x4*)(pTab + 32 * jt + 8 * gq);
#pragma unroll
                            for (int q = 0; q < 4; ++q) Xf[4 * gq + q] *= T[q]; }
                    } else {
#pragma unroll
                        for (int gq = 0; gq < 4; ++gq) { const int jl0 = 8 * gq + 4 * hh;
                            const f32x4 AF = *(const LAS f32x4*)(pArr + 32 * jt + 8 * gq), AB = *(const LAS f32x4*)(pArr + 128 + 32 * jt + 8 * gq), DF = *(const LAS f32x4*)(pArr + 256 + 32 * jt + 8 * gq), DB = *(const LAS f32x4*)(pArr + 384 + 32 * jt + 8 * gq);
#pragma unroll
                            for (int q = 0; q < 4; ++q) { const int jl = jl0 + q; const bool lower = jl < iv;
                                const float arg = lower ? aFi - AF[q] : aBi - AB[q]; float f = __expf(arg) * (lower ? DF[q] : DB[q]); f += (jl == iv) ? DF[q] : 0.f;
                                Xf[4 * gq + q] *= f; } }
                    }
                    bf16x8 mf[2], xa[2];
#pragma unroll
                    for (int ss = 0; ss < 2; ++ss) { v4u w; w.x = pk2(Xf[8 * ss + 0], Xf[8 * ss + 1]); w.y = pk2(Xf[8 * ss + 2], Xf[8 * ss + 3]); w.z = pk2(Xf[8 * ss + 4], Xf[8 * ss + 5]); w.w = pk2(Xf[8 * ss + 6], Xf[8 * ss + 7]);
                        mf[ss] = __builtin_bit_cast(bf16x8, w);
                        const v2u lo = tr_read(xrd + (32 * jt + 16 * ss) * 192), hi = tr_read(xrd + (32 * jt + 16 * ss + 8) * 192); v4u xw; xw.x = lo.x; xw.y = lo.y; xw.z = hi.x; xw.w = hi.y;
                        xa[ss] = __builtin_bit_cast(bf16x8, xw); }
                    if (jt != it) { tL = __builtin_amdgcn_mfma_f32_32x32x16_bf16(xa[0], mf[0], tL, 0, 0, 0); tL = __builtin_amdgcn_mfma_f32_32x32x16_bf16(xa[1], mf[1], tL, 0, 0, 0); }
                    else {
#pragma unroll
                        for (int k = 0; k < 16; ++k) { acc[k] += rowF * tL[k]; tL[k] = 0.f; }
                        acc = __builtin_amdgcn_mfma_f32_32x32x16_bf16(xa[0], mf[0], acc, 0, 0, 0); acc = __builtin_amdgcn_mfma_f32_32x32x16_bf16(xa[1], mf[1], acc, 0, 0, 0); }
                }
#pragma unroll
                for (int k = 0; k < 16; ++k) acc[k] += rowB * tL[k];
                {
                    const float Dh = ssd_d[head];
                    LAS unsigned char* pY = sY + i * 128; asm volatile("" : "+v"(pY));
#pragma unroll
                    for (int gq = 0; gq < 4; ++gq) {
                        const v2u xw = *(const LAS v2u*)(pXi + 16 * gq), zw = *(const LAS v2u*)(pZi + 16 * gq);
                        const float xv[4] = {bflo(xw.x), bfhi(xw.x), bflo(xw.y), bfhi(xw.y)}, zv[4] = {bflo(zw.x), bfhi(zw.x), bflo(zw.y), bfhi(zw.y)};
                        float y[4];
#pragma unroll
                        for (int q = 0; q < 4; ++q) { y[q] = (acc[4 * gq + q] + Dh * xv[q]) * siluf(zv[q]); ssq_acc += y[q] * y[q]; }
                        v2u w; w.x = pk2(y[0], y[1]); w.y = pk2(y[2], y[3]);
                        *(LAS v2u*)(pY + (((8 * pt + 2 * gq + hh) ^ (iv & 15)) << 3)) = w; }
                }
                __syncthreads();
                { const int tok = t2 >> 2, c16 = t2 & 3; const LAS unsigned char* src = sY + tok * 128; v2u c[4];
#pragma unroll
                  for (int k = 0; k < 4; ++k) c[k] = *(const LAS v2u*)(src + (((4 * c16 + k) ^ (tok & 15)) << 3));
                  bf16* dst = Yn + (size_t)(row0 + tok) * D + head * 64 + 16 * c16;
                  v4u w0; w0.x = c[0].x; w0.y = c[0].y; w0.z = c[1].x; w0.w = c[1].y; v4u w1; w1.x = c[2].x; w1.y = c[2].y; w1.z = c[3].x; w1.w = c[3].y;
                  *(v4u*)dst = w0; *(v4u*)(dst + 8) = w1; }
                if (hd < 7) {
#pragma unroll
                    for (int m = 0; m < 4; ++m) { const int q = t2 + 512 * m, which = q >> 10, r = (q & 1023) >> 4, ck = q & 15;
                        *(LAS v4u*)(sHF + which * 17408 + r * 272 + ck * 16) = pfh[m]; }
#pragma unroll
                    for (int m = 0; m < 2; ++m) { const int q = t2 + 512 * m, tok = q >> 3, ck = q & 7;
                        *(LAS v4u*)(sCz + tok * 192 + ck * 16) = pfz[m];
                        *(LAS v4u*)(sX + tok * 192 + ck * 16) = pxc[m]; }
                }
                __syncthreads();
            }
#undef P6_WRITE_TABLES
            ssq_acc += __shfl_xor(ssq_acc, 32);
            if (lane < 32) SSQ[pt * 128 + i] = ssq_acc;
            VM_WAIT();
            __syncthreads();
            {
                v4u wv[16];
                bf16* yb = Yn + (size_t)(row0 + wave * 16) * D + grp * 512 + lane * 8;
#pragma unroll
                for (int r = 0; r < 16; ++r) wv[r] = *(const v4u*)(yb + (size_t)r * D);
#pragma unroll
                for (int r = 0; r < 16; ++r) { const float tot = SSQ[wave * 16 + r] + SSQ[128 + wave * 16 + r];
                    const float rstd = 1.0f / sqrtf(tot * (1.f / 512.f) + EPS);
                    float t[8]; unpack8(wv[r], t);
#pragma unroll
                    for (int e = 0; e < 8; ++e) t[e] *= rstd;
                    *(v4u*)(yb + (size_t)r * D) = pack8(t); }
            }
        }
        __syncthreads();
        if (BOTH(5)) GRID_BAR();
    }

    if (IN(6)) { PHASE_BASES();
        { pg8::Gemm g{Yn, WSSD, M, D, D, SCY, WSC}; OrderTwice S; S.so.init(M, D, G, bx); S.R = (512 + G - 1) / G; EpiGate E{Gt, b_gate, MERGED};
          pg8::gemm_phase<EpiGate, OrderTwice, true, true>(lds, g, S, E); }
        if (BOTH(6)) GRID_BAR();
    }

    if (IN(7)) { PHASE_BASES();
        pg8::Gemm g{MERGED, WO, M, D, D}; pg8::StaticOrder S; S.init(M, D, G, bx); EpiBf16Plain E{OUTX, D};
        pg8::gemm_phase<EpiBf16Plain, pg8::StaticOrder, true, true>(lds, g, S, E);
        if (BOTH(7)) GRID_BAR();
    }

    if (IN(8)) { PHASE_BASES();
        LAS float* wrT = (LAS float*)lds;
        for (int ch = tid; ch < D; ch += NWAVES * 64) { f32x4 wv[4];
#pragma unroll
            for (int q = 0; q < 4; ++q) wv[q] = ((const f32x4*)(w_router + (size_t)ch * NE))[q];
#pragma unroll
            for (int q = 0; q < 4; ++q) { wrT[(4 * q + 0) * D + ch] = wv[q].x; wrT[(4 * q + 1) * D + ch] = wv[q].y; wrT[(4 * q + 2) * D + ch] = wv[q].z; wrT[(4 * q + 3) * D + ch] = wv[q].w; } }
        __syncthreads();
        LAS f32x4* pv = (LAS f32x4*)(lds + 131072);
        for (int trip = 0; trip * 2 * NGW < M; ++trip) {
            const int row0 = 2 * gw + trip * 2 * NGW; const int b = (16 * bx + trip * 2 * NGW) / SEQ;
            __syncthreads();
            { const float* md = MODX + b * MODW;
              for (int c4 = tid; c4 < D / 4; c4 += NWAVES * 64) { const f32x4 gpm = ((const f32x4*)n_post_mix)[c4], gx = ((const f32x4*)(md + 2 * D))[c4], gpf = ((const f32x4*)n_pre_ffn)[c4], s0 = ((const f32x4*)(md + 3 * D))[c4], s1 = ((const f32x4*)(md + 4 * D))[c4];
                  pv[c4] = gx * gpm; pv[D / 4 + c4] = gpf * (s1 + 1.0f); pv[2 * (D / 4) + c4] = s0; } }
            __syncthreads();
            if (row0 >= M) continue;
            f32x4 va[8], vb[8];
            v2u owa[8], owb[8]; f32x4 xra[8], xrb[8];
#pragma unroll
            for (int j = 0; j < 8; ++j) { owa[j] = __builtin_nontemporal_load((const v2u*)(OUTX + (size_t)row0 * D) + lane + 64 * j); owb[j] = __builtin_nontemporal_load((const v2u*)(OUTX + (size_t)(row0 + 1) * D) + lane + 64 * j); }
#pragma unroll
            for (int j = 0; j < 8; ++j) { xra[j] = __builtin_nontemporal_load((const f32x4*)(in_x + (size_t)row0 * D) + lane + 64 * j); xrb[j] = __builtin_nontemporal_load((const f32x4*)(in_x + (size_t)(row0 + 1) * D) + lane + 64 * j); }
#pragma unroll
            for (int rr = 0; rr < 2; ++rr) {
                const int row = row0 + rr; f32x4 v[8]; float ss = 0.f;
#pragma unroll
                for (int j = 0; j < 8; ++j) { const v2u ow = rr ? owb[j] : owa[j]; v[j] = (f32x4){bflo(ow.x), bfhi(ow.x), bflo(ow.y), bfhi(ow.y)}; ss += (v[j].x * v[j].x + v[j].y * v[j].y) + (v[j].z * v[j].z + v[j].w * v[j].w); }
                const float rstd1 = 1.0f / sqrtf(wave_sum(ss) * (1.f / D) + EPS);
                float ss2 = 0.f;
#pragma unroll
                for (int j = 0; j < 8; ++j) { const f32x4 xr = rr ? xrb[j] : xra[j], a1 = pv[lane + 64 * j];
                    v[j] = xr + a1 * (v[j] * rstd1); ((f32x4*)(out + (size_t)row * D))[lane + 64 * j] = v[j];
                    ss2 += (v[j].x * v[j].x + v[j].y * v[j].y) + (v[j].z * v[j].z + v[j].w * v[j].w); }
                const float rstd2 = 1.0f / sqrtf(wave_sum(ss2) * (1.f / D) + EPS);
                v2u* o8 = (v2u*)(HX2 + (size_t)row * D) + lane;
#pragma unroll
                for (int j = 0; j < 8; ++j) { const f32x4 a2 = pv[D / 4 + lane + 64 * j], a3 = pv[2 * (D / 4) + lane + 64 * j];
                    v[j] = (v[j] * rstd2) * a2 + a3; v2u w; w.x = pk2(v[j].x, v[j].y); w.y = pk2(v[j].z, v[j].w); o8[64 * j] = w;
                    if (rr == 0) va[j] = v[j]; else vb[j] = v[j]; }
            }
            float q8a[8], q8b[8];
            const bool h5 = (lane & 32) != 0, h4 = (lane & 16) != 0, h3 = (lane & 8) != 0, h2 = (lane & 4) != 0;
#pragma unroll
            for (int e = 0; e < 8; ++e) {
                pg8::f32x2 pa0 = {0.f, 0.f}, pb0 = pa0, pa1 = pa0, pb1 = pa0;
                { __builtin_amdgcn_sched_barrier(0);
                  f32x4 w0[8];
#pragma unroll
                  for (int j = 0; j < 8; ++j) w0[j] = ((const LAS f32x4*)(wrT + e * D))[lane + 64 * j];
#pragma unroll
                  for (int j = 0; j < 8; ++j) {
                    pa0 = __builtin_elementwise_fma(va[j].xy, w0[j].xy, pa0); pa0 = __builtin_elementwise_fma(va[j].zw, w0[j].zw, pa0);
                    pb0 = __builtin_elementwise_fma(vb[j].xy, w0[j].xy, pb0); pb0 = __builtin_elementwise_fma(vb[j].zw, w0[j].zw, pb0); } }
                { __builtin_amdgcn_sched_barrier(0);
                  f32x4 w1[8];
#pragma unroll
                  for (int j = 0; j < 8; ++j) w1[j] = ((const LAS f32x4*)(wrT + (e + 8) * D))[lane + 64 * j];
#pragma unroll
                  for (int j = 0; j < 8; ++j) {
                    pa1 = __builtin_elementwise_fma(va[j].xy, w1[j].xy, pa1); pa1 = __builtin_elementwise_fma(va[j].zw, w1[j].zw, pa1);
                    pb1 = __builtin_elementwise_fma(vb[j].xy, w1[j].xy, pb1); pb1 = __builtin_elementwise_fma(vb[j].zw, w1[j].zw, pb1); } }
                const float sa0 = pa0.x + pa0.y, sb0 = pb0.x + pb0.y, sa1 = pa1.x + pa1.y, sb1 = pb1.x + pb1.y;
                { const float r = __shfl_xor(h5 ? sa0 : sa1, 32); q8a[e] = (h5 ? sa1 : sa0) + r; }
                { const float r = __shfl_xor(h5 ? sb0 : sb1, 32); q8b[e] = (h5 ? sb1 : sb0) + r; }
                __builtin_amdgcn_sched_barrier(0); }
#pragma unroll
            for (int rr = 0; rr < 2; ++rr) {
                float q8[8], q4[4], q2[2], q1;
#pragma unroll
                for (int k = 0; k < 8; ++k) q8[k] = rr ? q8b[k] : q8a[k];
#pragma unroll
                for (int k = 0; k < 4; ++k) { const float r = __shfl_xor(h4 ? q8[k] : q8[k + 4], 16); q4[k] = (h4 ? q8[k + 4] : q8[k]) + r; }
#pragma unroll
                for (int k = 0; k < 2; ++k) { const float r = __shfl_xor(h3 ? q4[k] : q4[k + 2], 8); q2[k] = (h3 ? q4[k + 2] : q4[k]) + r; }
                { const float r = __shfl_xor(h2 ? q2[0] : q2[1], 4); q1 = (h2 ? q2[1] : q2[0]) + r; }
                q1 += __shfl_xor(q1, 2); q1 += __shfl_xor(q1, 1);
                float mx = q1;
#pragma unroll
                for (int o = 4; o < 64; o <<= 1) mx = fmaxf(mx, __shfl_xor(mx, o));
                const float ex = expf(q1 - mx); float den = ex;
#pragma unroll
                for (int o = 4; o < 64; o <<= 1) den += __shfl_xor(den, o);
                const int t = (row0 + rr) % SEQ;
                if ((lane & 3) == 0) AFF[(size_t)(b * NE + (lane >> 2)) * SEQ + t] = ex / den;
            }
        }
        __syncthreads();
        if (BOTH(8)) GRID_BAR();
    }

    if (IN(9)) { PHASE_BASES();
        {
            LAS unsigned* hist = (LAS unsigned*)lds;
            LAS unsigned* shv = hist + 256;
            for (int be = bx; be < NB * NE; be += G) {
                const f32x4 va = ((const f32x4*)(AFF + (size_t)be * SEQ))[2 * tid], vb = ((const f32x4*)(AFF + (size_t)be * SEQ))[2 * tid + 1];
                float vals[8] = {va.x, va.y, va.z, va.w, vb.x, vb.y, vb.z, vb.w};
                unsigned key[8];
#pragma unroll
                for (int k = 0; k < 8; ++k) { const unsigned u = __builtin_bit_cast(unsigned, vals[k]); key[k] = (u & 0x80000000u) ? ~u : (u | 0x80000000u); }
                unsigned prefix = 0u, mask = 0u, need = (unsigned)CAP;
#pragma unroll 1
                for (int pass = 0; pass < 4; ++pass) {
                    const int shift = 24 - 8 * pass;
                    __syncthreads();
                    if (tid < 256) hist[tid] = 0u;
                    __syncthreads();
#pragma unroll
                    for (int k = 0; k < 8; ++k) if ((key[k] & mask) == prefix) __hip_atomic_fetch_add(&hist[(key[k] >> shift) & 255u], 1u, __ATOMIC_RELAXED, __HIP_MEMORY_SCOPE_WORKGROUP);
                    __syncthreads();
                    unsigned mine = 0u, incl = 0u;
                    if (wave < 4) { mine = hist[tid]; incl = mine;
#pragma unroll
                        for (int o = 1; o < 64; o <<= 1) { const unsigned t = __shfl_down(incl, o); if (lane + o < 64) incl += t; }
                        if (lane == 0) shv[24 + wave] = incl; }
                    __syncthreads();
                    if (wave < 4) { unsigned above = incl - mine;
                        for (int w = wave + 1; w < 4; ++w) above += shv[24 + w];
                        if (above < need && above + mine >= need) { shv[0] = prefix | ((unsigned)tid << shift); shv[1] = need - above; } }
                    __syncthreads();
                    prefix = shv[0]; need = shv[1]; mask |= 0xffu << shift;
                }
                const unsigned thr = prefix;
                unsigned cg_ = 0u, ce_ = 0u;
#pragma unroll
                for (int k = 0; k < 8; ++k) { cg_ += key[k] > thr ? 1u : 0u; ce_ += key[k] == thr ? 1u : 0u; }
                unsigned ig = cg_, ie = ce_;
#pragma unroll
                for (int o = 1; o < 64; o <<= 1) { const unsigned tg = __shfl_up(ig, o), te = __shfl_up(ie, o); if (lane >= o) { ig += tg; ie += te; } }
                if (lane == 63) { shv[8 + wave] = ig; shv[16 + wave] = ie; }
                __syncthreads();
                unsigned og = ig - cg_, oe = ie - ce_;
                for (int w = 0; w < wave; ++w) { og += shv[8 + w]; oe += shv[16 + w]; }
#pragma unroll
                for (int k = 0; k < 8; ++k) { const int t = 8 * tid + k; const bool gt = key[k] > thr, eq = key[k] == thr; const bool sel = gt || (eq && oe < need);
                    const unsigned slot = og + (oe < need ? oe : need);
                    if (sel) { IDX[be * CAP + slot] = (be / NE) * SEQ + t; VAL[be * CAP + slot] = vals[k]; }
                    SLOT[(size_t)be * SEQ + t] = sel ? (int)slot : -1;
                    og += gt ? 1u : 0u; oe += eq ? 1u : 0u; }
            }
            __syncthreads();
        }
        { const ExpertCopy X{w_e1, w_e3, w_e2, W13, W2}; expert_copy_share(X, ctl + CW_Q1, lane); }
        if (BOTH(9)) GRID_BAR();
    }

    if (IN(10)) { PHASE_BASES();
        pg8::Gemm g{HX2, W13, NB * NE * CAP, NE * 2 * FF, D}; OrderMoe<16> S; S.init(G, bx); EpiMoe1 E{ACT};
        pg8::gemm_phase_gather<EpiMoe1, OrderMoe<16>>(lds, g, IDX, (LAS int*)(lds + 131072), S, E);
        if (BOTH(10)) GRID_BAR();
    }

    if (IN(11)) { PHASE_BASES();
        pg8::Gemm g{ACT, W2, NB * NE * CAP, NE * D, FF}; OrderMoe<8> S; S.init(G, bx); EpiMoe2 E{OUTE, VAL};
        pg8::gemm_phase<EpiMoe2, OrderMoe<8>, true, true>(lds, g, S, E);
        if (BOTH(11)) GRID_BAR();
    }

    if (IN(12)) { PHASE_BASES();
        for (int row = gw; row < M; row += NGW) {
            const int b = row / SEQ, t = row % SEQ; const float* md = MODX + b * MODW;
            const int myslot = lane < NE ? SLOT[(size_t)(b * NE + lane) * SEQ + t] : -1;
            f32x4 xo[8], pg[8], pf[8];
#pragma unroll
            for (int j = 0; j < 8; ++j) xo[j] = __builtin_nontemporal_load((const f32x4*)(out + (size_t)row * D) + lane + 64 * j);
#pragma unroll
            for (int j = 0; j < 8; ++j) { pg[j] = ((const f32x4*)n_post_ffn)[lane + 64 * j]; pf[j] = ((const f32x4*)(md + 5 * D))[lane + 64 * j]; }
            f32x4 acc[8];
#pragma unroll
            for (int j = 0; j < 8; ++j) acc[j] = (f32x4){0.f, 0.f, 0.f, 0.f};
            unsigned long long sel = __ballot(myslot >= 0);
            while (sel) { const int e = __builtin_ctzll(sel); sel &= sel - 1; const int s = __shfl(myslot, e);
                const v2u* src = (const v2u*)(OUTE + (size_t)((b * NE + e) * CAP + s) * D);
#pragma unroll
                for (int j = 0; j < 8; ++j) { const v2u w = __builtin_nontemporal_load(src + lane + 64 * j); acc[j] += (f32x4){bflo(w.x), bfhi(w.x), bflo(w.y), bfhi(w.y)}; } }
            float ss = 0.f;
#pragma unroll
            for (int j = 0; j < 8; ++j) ss += (acc[j].x * acc[j].x + acc[j].y * acc[j].y) + (acc[j].z * acc[j].z + acc[j].w * acc[j].w);
            const float rstd = 1.0f / sqrtf(wave_sum(ss) * (1.f / D) + EPS);
#pragma unroll
            for (int j = 0; j < 8; ++j) __builtin_nontemporal_store(xo[j] + pf[j] * (acc[j] * rstd * pg[j]), (f32x4*)(out + (size_t)row * D) + lane + 64 * j);
        }
    }
#undef in_x
#undef cvec
#undef ctx
#undef c_ctx
#undef w_mod
#undef b_mod
#undef n_pre_mix
#undef n_post_mix
#undef w_in
#undef ssd_conv_w
#undef ssd_conv_b
#undef dt_bias
#undef a_log
#undef ssd_d
#undef ssd_norm_w
#undef w_ssd_out
#undef sc_conv_w
#undef w_sc_out
#undef b_gate
#undef w_o
#undef n_pre_ffn
#undef n_post_ffn
#undef w_router
#undef w_e1
#undef w_e3
#undef w_e2
#undef out
#undef MODX
#undef MODC
#undef AFF
#undef SLOT
#undef IDX
#undef VAL
#undef DTS
#undef WIN
#undef WSSD
#undef WSC
#undef WO
#undef HX
#undef Zb
#undef XBC
#undef XBCR
#undef Gt
#undef SCY
#undef ST
#undef HENT
#undef CHLOG
#undef Yn
#undef MERGED
#undef OUTX
#undef HX2
#undef W13
#undef W2
#undef ACT
#undef OUTE
#undef KARG
#undef PHASE_BASES
#undef KAS
#undef IN
#undef BOTH
#undef GRID_BAR
}

extern "C" void kernel_launch(void* const* d_in, const int* in_sizes, int n_in, void* d_out, int out_size, void* d_ws, size_t ws_size, hipStream_t stream) {
    static int grid = 0;
    if (grid == 0) {
        if (n_in != 26 || in_sizes[0] != M * D || out_size != M * D || ws_size < WS_END) { fprintf(stderr, "kernel_launch: unexpected shapes (n_in %d, in0 %d, out %d, ws %zu < %zu); nothing launched\n", n_in, n_in > 0 ? in_sizes[0] : -1, out_size, ws_size, (size_t)WS_END); grid = -1; return; }
        int dev = 0, cus = 0, per_cu = 0;
        if (hipGetDevice(&dev) != hipSuccess || hipDeviceGetAttribute(&cus, hipDeviceAttributeMultiprocessorCount, dev) != hipSuccess) { grid = -1; return; }
        if (hipFuncSetAttribute((const void*)mk_fwd, hipFuncAttributeMaxDynamicSharedMemorySize, LDS_BYTES) != hipSuccess) { fprintf(stderr, "kernel_launch: hipFuncSetAttribute failed\n"); grid = -1; return; }
        if (hipOccupancyMaxActiveBlocksPerMultiprocessor(&per_cu, (const void*)mk_fwd, NWAVES * 64, LDS_BYTES) != hipSuccess || per_cu < 1)
            fprintf(stderr, "kernel_launch: note: occupancy query reports %d workgroups per CU\n", per_cu);
        (void)hipGetLastError();
        grid = cus;
    }
    if (grid < 0) return;
    if (hipMemsetAsync((char*)d_ws + WS_CTL, 0, CTL_ZERO_BYTES, stream) != hipSuccess) { fprintf(stderr, "kernel_launch: memset failed\n"); return; }
    Args a{};
    for (int i = 0; i < 26; ++i) a.in[i] = (const float*)d_in[i];
    a.out = (float*)d_out; a.ws = (unsigned char*)d_ws;
#if MK_N_LAUNCHES == 1
    a.ph_lo = 0; a.ph_hi = NPHASES;
    hipLaunchKernelGGL(mk_fwd, dim3(grid), dim3(NWAVES * 64), LDS_BYTES, stream, a);
#else
    for (int p = 0; p < NPHASES; ++p) { a.ph_lo = p; a.ph_hi = p + 1; hipLaunchKernelGGL(mk_fwd, dim3(grid), dim3(NWAVES * 64), LDS_BYTES, stream, a); }
#endif
    const hipError_t le = hipPeekAtLastError();
    if (le != hipSuccess) fprintf(stderr, "kernel_launch: launch failed: %s\n", hipGetErrorName(le));
}
```

```cpp
#include <hip/hip_runtime.h>
#include <cstdio>
#include <cstdint>
namespace pg8 {
#define PG8_LAS __attribute__((address_space(3)))
typedef unsigned short bf16_t;
typedef short bf16x8 __attribute__((ext_vector_type(8)));
typedef float f32x4 __attribute__((ext_vector_type(4)));
typedef unsigned u32x4 __attribute__((ext_vector_type(4)));
constexpr int BM = 256, BK = 64, HALF = 128, HTB = HALF * BK * 2  , STAGE_BYTES = 8 * HTB, NXCD = 8, WGM = 8;

__host__ __device__ __forceinline__ int lds_byte(int r, int c) { const int st = (r >> 4) * 2 + (c >> 5), rr = r & 15, cc = c & 31, ob = rr * 64 + cc * 2; return st * 1024 + (ob ^ (((ob >> 9) & 1) << 5)); }
__host__ __device__ __forceinline__ void stage_rc(int b, int& R, int& C) { const int st = b / 1024, sb = b % 1024, swz = sb ^ (((sb >> 9) & 1) << 5); R = (st >> 1) * 16 + swz / 64; C = (st & 1) * 32 + (swz % 64) / 2; }
__host__ __device__ __forceinline__ int perm32(int rho) { const int n = rho >> 4, i = rho & 15; return 8 * (i >> 2) + 4 * n + (i & 3); }

struct Unit { int pm, pn; int sel = 0; };
struct Gemm { const bf16_t* A; const bf16_t* Bt; int M, N, K; const bf16_t* A2 = nullptr; const bf16_t* Bt2 = nullptr; };

struct StaticOrder {
    static constexpr bool DYNAMIC = false;
    int nM, nN, nwg, G, c;
    __host__ __device__ __forceinline__ void init(int M, int N, int G_, int c_) { nM = M / BM; nN = N / BM; nwg = nM * nN; G = G_; c = c_; }
    __host__ __device__ __forceinline__ bool next(int i, Unit& u) const {
        const long L = (long)i * G + c; if (L >= nwg) return false;
        int wgid = (int)L; { const int q = nwg / NXCD, r = nwg % NXCD, xcd = wgid % NXCD, off = wgid / NXCD; wgid = (xcd < r ? xcd * (q + 1) : r * (q + 1) + (xcd - r) * q) + off; }
        const int nig = WGM * nN, gid = wgid / nig, fm = gid * WGM, gsz = (nM - fm) < WGM ? (nM - fm) : WGM;
        u.pm = fm + ((wgid % nig) % gsz); u.pn = (wgid % nig) / gsz; return true;
    }
    __device__ __forceinline__ void a_ready(const Unit&) const {}
    __device__ __forceinline__ void done(const Unit&) const {}
};

__device__ __forceinline__ unsigned cvt_pk_bf16(float lo, float hi) { unsigned r; asm volatile("v_cvt_pk_bf16_f32 %0, %1, %2" : "=v"(r) : "v"(lo), "v"(hi)); return r; }
typedef float f32x2 __attribute__((ext_vector_type(2)));
template <class Epi, class Sched, bool ALIGN_EPI = false, bool SP2 = false>
__device__ __forceinline__ void gemm_phase(PG8_LAS unsigned char* lds, const Gemm g, const Sched& S, const Epi& E) {
    const int tid = threadIdx.x, wid = __builtin_amdgcn_readfirstlane(tid >> 6), lane = tid & 63, wr = wid >> 2, wc = wid & 3, fr = lane & 15, fq = lane >> 4;
    const int K = g.K, nt = K / BK;
    unsigned voffA[2], voffB[2];
#pragma unroll
    for (int i = 0; i < 2; ++i) { int R, C; stage_rc(tid * 16 + i * 8192, R, C); const int Rb = Epi::PERM ? ((R & ~31) + perm32(R & 31)) : R;
        voffA[i] = (unsigned)(R * K + C) * 2u; voffB[i] = (unsigned)(Rb * K + C) * 2u; }
    const size_t kstep = (size_t)(BK * 2);
    const size_t hstep = (size_t)HALF * K * 2;
    const size_t tstep = 2 * hstep;
    const unsigned ldsw = (unsigned)wid * 1024u;
    const int aoff = lds_byte(wr * 64 + fr, fq * 8), boff = lds_byte(wc * 32 + fr, fq * 8);
#define PG8_SA(b, h) (((b) * 2 + (h)) * HTB)
#define PG8_SB(b, h) ((4 + (b) * 2 + (h)) * HTB)
#define PG8_STAGE(bufoff, gbase, voff) do { _Pragma("unroll") for (int _i = 0; _i < 2; ++_i) \
        __builtin_amdgcn_global_load_lds((const unsigned*)((const char*)(gbase) + (voff)[_i]), (PG8_LAS unsigned*)(lds + (bufoff) + ldsw + _i * 8192), 16, 0, 0); } while (0)
#define PG8_LDA(dst, b, h) do { _Pragma("unroll") for (int m = 0; m < 4; ++m) _Pragma("unroll") for (int k = 0; k < 2; ++k) dst[m][k] = *(const PG8_LAS bf16x8*)(lds + PG8_SA(b, h) + aoff + m * 2048 + k * 1024); } while (0)
#define PG8_LDB(dst, b, h) do { _Pragma("unroll") for (int n = 0; n < 2; ++n) _Pragma("unroll") for (int k = 0; k < 2; ++k) dst[n][k] = *(const PG8_LAS bf16x8*)(lds + PG8_SB(b, h) + boff + n * 2048 + k * 1024); } while (0)
#define PG8_MMA(ai, bj, At, Bt) do { __builtin_amdgcn_s_setprio(1); _Pragma("unroll") for (int m = 0; m < 4; ++m) _Pragma("unroll") for (int n = 0; n < 2; ++n) _Pragma("unroll") for (int k = 0; k < 2; ++k) \
        acc[ai][bj][m][n] = __builtin_amdgcn_mfma_f32_16x16x32_bf16(Bt[n][k], At[m][k], acc[ai][bj][m][n], 0, 0, 0); __builtin_amdgcn_s_setprio(0); } while (0)
#define PG8_WAIT_V(n) asm volatile("s_waitcnt vmcnt(" #n ")" ::: "memory")
#define PG8_WAIT_L(n) asm volatile("s_waitcnt lgkmcnt(" #n ")" ::: "memory")
#define PG8_BAR __builtin_amdgcn_s_barrier()
#define PG8_SCHED __builtin_amdgcn_sched_barrier(0)
    Unit cur, nxt; int ui = 0;
    if (!S.next(0, cur)) return;
    f32x4 acc[2][2][4][2];
#pragma unroll
    for (int a = 0; a < 2; ++a)
#pragma unroll
        for (int b = 0; b < 2; ++b)
#pragma unroll
            for (int m = 0; m < 4; ++m)
#pragma unroll
                for (int n = 0; n < 2; ++n) acc[a][b][m][n] = (f32x4){0.f, 0.f, 0.f, 0.f};
    bf16x8 At[4][2], B0[2][2], B1[2][2];
    const char* cA = (const char*)(cur.sel ? g.A2 : g.A) + (size_t)cur.pm * tstep; const char* cB = (const char*)(cur.sel ? g.Bt2 : g.Bt) + (size_t)cur.pn * tstep;
    S.a_ready(cur);
    if constexpr (SP2) {
        PG8_STAGE(PG8_SB(0, 0), cB, voffB); PG8_STAGE(PG8_SB(0, 1), cB + hstep, voffB); PG8_STAGE(PG8_SA(0, 0), cA, voffA); PG8_STAGE(PG8_SA(0, 1), cA + hstep, voffA);
        if (wr == 1) PG8_BAR;
        PG8_WAIT_V(2); PG8_BAR;
        PG8_STAGE(PG8_SB(1, 0), cB + kstep, voffB); PG8_STAGE(PG8_SA(1, 0), cA + kstep, voffA); PG8_STAGE(PG8_SB(1, 1), cB + hstep + kstep, voffB);
        PG8_WAIT_V(6); PG8_BAR;
    } else {
        PG8_STAGE(PG8_SB(0, 0), cB, voffB); PG8_STAGE(PG8_SA(0, 0), cA, voffA); PG8_STAGE(PG8_SB(0, 1), cB + hstep, voffB); PG8_STAGE(PG8_SA(0, 1), cA + hstep, voffA);
        if (wr == 1) PG8_BAR;
        PG8_WAIT_V(4); PG8_BAR;
        PG8_STAGE(PG8_SB(1, 0), cB + kstep, voffB); PG8_STAGE(PG8_SA(1, 0), cA + kstep, voffA); PG8_STAGE(PG8_SB(1, 1), cB + hstep + kstep, voffB);
        PG8_WAIT_V(6); PG8_BAR;
    }
    for (;;) {
        const bool has_next = S.next(ui + 1, nxt);
        unsigned pend = 0u; if constexpr (Sched::DYNAMIC) pend = S.claim_issue(wid, lane);
        const char* nA = has_next ? (const char*)(nxt.sel ? g.A2 : g.A) + (size_t)nxt.pm * tstep : cA; const char* nB = has_next ? (const char*)(nxt.sel ? g.Bt2 : g.Bt) + (size_t)nxt.pn * tstep : cB;
        for (int t = 0; t < nt; t += 2) {
            const bool last = (t == nt - 2);
            const char* a1 = cA + (size_t)(t + 1) * kstep;
            const char* a2 = last ? nA : cA + (size_t)(t + 2) * kstep; const char* b2 = last ? nB : cB + (size_t)(t + 2) * kstep;
            const char* a3 = a2 + kstep; const char* b3 = b2 + kstep;
            if (last && has_next) S.a_ready(nxt);
            if constexpr (SP2) {
            PG8_LDB(B0, 0, 0); PG8_LDB(B1, 0, 1); PG8_SCHED; PG8_LDA(At, 0, 0); PG8_STAGE(PG8_SA(1, 1), a1 + hstep, voffA);
            PG8_WAIT_V(8); PG8_WAIT_L(0); PG8_BAR; PG8_MMA(0, 0, At, B0); PG8_MMA(0, 1, At, B1); PG8_BAR; PG8_SCHED;
            PG8_LDA(At, 0, 1); PG8_STAGE(PG8_SB(0, 0), b2, voffB); PG8_STAGE(PG8_SB(0, 1), b2 + hstep, voffB); PG8_STAGE(PG8_SA(0, 0), a2, voffA);
            PG8_WAIT_V(8); PG8_WAIT_L(0); PG8_BAR; PG8_MMA(1, 0, At, B0); PG8_MMA(1, 1, At, B1); PG8_BAR; PG8_SCHED;
            PG8_LDB(B0, 1, 0); PG8_LDB(B1, 1, 1); PG8_SCHED; PG8_LDA(At, 1, 0); PG8_STAGE(PG8_SA(0, 1), a2 + hstep, voffA);
            PG8_WAIT_V(8); PG8_WAIT_L(0); PG8_BAR; PG8_MMA(0, 0, At, B0); PG8_MMA(0, 1, At, B1); PG8_BAR; PG8_SCHED;
            PG8_LDA(At, 1, 1); PG8_STAGE(PG8_SB(1, 0), b3, voffB); PG8_STAGE(PG8_SB(1, 1), b3 + hstep, voffB); PG8_STAGE(PG8_SA(1, 0), a3, voffA);
            PG8_WAIT_V(8); PG8_WAIT_L(0); PG8_BAR; PG8_MMA(1, 0, At, B0); PG8_MMA(1, 1, At, B1); PG8_BAR; PG8_SCHED;
            } else {
            PG8_LDB(B0, 0, 0); PG8_SCHED; PG8_LDA(At, 0, 0); PG8_STAGE(PG8_SA(1, 1), a1 + hstep, voffA);
            PG8_WAIT_L(8); PG8_BAR; PG8_WAIT_L(0); PG8_MMA(0, 0, At, B0); PG8_BAR; PG8_SCHED;
            PG8_LDB(B1, 0, 1); PG8_STAGE(PG8_SB(0, 0), b2, voffB);
            PG8_BAR; PG8_WAIT_L(0); PG8_MMA(0, 1, At, B1); PG8_BAR;
            PG8_LDA(At, 0, 1); PG8_STAGE(PG8_SA(0, 0), a2, voffA);
            PG8_BAR; PG8_WAIT_L(0); PG8_MMA(1, 0, At, B0); PG8_BAR; PG8_SCHED;
            PG8_STAGE(PG8_SB(0, 1), b2 + hstep, voffB);
            PG8_WAIT_V(6); PG8_BAR; PG8_MMA(1, 1, At, B1); PG8_BAR;
            PG8_LDB(B0, 1, 0); PG8_SCHED; PG8_LDA(At, 1, 0); PG8_STAGE(PG8_SA(0, 1), a2 + hstep, voffA);
            PG8_WAIT_L(8); PG8_BAR; PG8_WAIT_L(0); PG8_MMA(0, 0, At, B0); PG8_BAR; PG8_SCHED;
            PG8_LDB(B1, 1, 1); PG8_STAGE(PG8_SB(1, 0), b3, voffB);
            PG8_BAR; PG8_WAIT_L(0); PG8_MMA(0, 1, At, B1); PG8_BAR;
            PG8_LDA(At, 1, 1); PG8_STAGE(PG8_SA(1, 0), a3, voffA);
            PG8_BAR; PG8_WAIT_L(0); PG8_MMA(1, 0, At, B0); PG8_BAR; PG8_SCHED;
            PG8_STAGE(PG8_SB(1, 1), b3 + hstep, voffB);
            PG8_WAIT_V(6); PG8_BAR; PG8_MMA(1, 1, At, B1); PG8_BAR;
            }
        }
        if constexpr (Sched::DYNAMIC) { static_assert(!Sched::DYNAMIC || ALIGN_EPI, "dynamic orders publish in front of the ALIGN_EPI barrier"); S.claim_publish(ui + 2, pend, wid, lane); }
        if constexpr (ALIGN_EPI) { if (wr == 0) PG8_BAR; }
        if constexpr (!Epi::AFTER_DRAIN) { E(acc, cur, wr, wc, fr, fq); S.done(cur); }
        if (!has_next) break;
#pragma unroll
        for (int a = 0; a < 2; ++a)
#pragma unroll
            for (int b = 0; b < 2; ++b)
#pragma unroll
                for (int m = 0; m < 4; ++m)
#pragma unroll
                    for (int n = 0; n < 2; ++n) acc[a][b][m][n] = (f32x4){0.f, 0.f, 0.f, 0.f};
        cur = nxt; cA = nA; cB = nB; ++ui;
        if constexpr (ALIGN_EPI) { if (wr == 1) PG8_BAR; }
    }
    PG8_WAIT_V(0);
    if constexpr (!ALIGN_EPI) { if (wr == 0) PG8_BAR; }
    PG8_BAR;
    if constexpr (Epi::AFTER_DRAIN) { E.fused(acc, cur, wr, wc, fr, fq, lds, wid, lane); S.done(cur); }
#undef PG8_SA
#undef PG8_SB
#undef PG8_STAGE
#undef PG8_LDA
#undef PG8_LDB
#undef PG8_MMA
#undef PG8_WAIT_V
#undef PG8_WAIT_L
#undef PG8_BAR
#undef PG8_SCHED
}

template <class Epi, class Sched>
__device__ __forceinline__ void gemm_phase_gather(PG8_LAS unsigned char* lds, const Gemm g, const int* __restrict__ gidx, PG8_LAS int* itab  , const Sched& S, const Epi& E) {
    const int tid = threadIdx.x, wid = __builtin_amdgcn_readfirstlane(tid >> 6), lane = tid & 63, wr = wid >> 2, wc = wid & 3, fr = lane & 15, fq = lane >> 4;
    const int K = g.K, nt = K / BK;
    int RA[2], CA[2]; unsigned voffB[2];
#pragma unroll
    for (int i = 0; i < 2; ++i) { int R, C; stage_rc(tid * 16 + i * 8192, R, C); const int Rb = Epi::PERM ? ((R & ~31) + perm32(R & 31)) : R;
        RA[i] = R; CA[i] = C; voffB[i] = (unsigned)(Rb * K + C) * 2u; }
    const size_t kstep = (size_t)(BK * 2);
    const size_t hstep = (size_t)HALF * K * 2;
    const size_t tstep = 2 * hstep;
    const unsigned ldsw = (unsigned)wid * 1024u;
    const int aoff = lds_byte(wr * 64 + fr, fq * 8), boff = lds_byte(wc * 32 + fr, fq * 8);
#define PG8_SA(b, h) (((b) * 2 + (h)) * HTB)
#define PG8_SB(b, h) ((4 + (b) * 2 + (h)) * HTB)
#define PG8_STAGE(bufoff, gbase, voff) do { _Pragma("unroll") for (int _i = 0; _i < 2; ++_i) \
        __builtin_amdgcn_global_load_lds((const unsigned*)((const char*)(gbase) + (voff)[_i]), (PG8_LAS unsigned*)(lds + (bufoff) + ldsw + _i * 8192), 16, 0, 0); } while (0)
#define PG8_LDA(dst, b, h) do { _Pragma("unroll") for (int m = 0; m < 4; ++m) _Pragma("unroll") for (int k = 0; k < 2; ++k) dst[m][k] = *(const PG8_LAS bf16x8*)(lds + PG8_SA(b, h) + aoff + m * 2048 + k * 1024); } while (0)
#define PG8_LDB(dst, b, h) do { _Pragma("unroll") for (int n = 0; n < 2; ++n) _Pragma("unroll") for (int k = 0; k < 2; ++k) dst[n][k] = *(const PG8_LAS bf16x8*)(lds + PG8_SB(b, h) + boff + n * 2048 + k * 1024); } while (0)
#define PG8_MMA(ai, bj, At, Bt) do { __builtin_amdgcn_s_setprio(1); _Pragma("unroll") for (int m = 0; m < 4; ++m) _Pragma("unroll") for (int n = 0; n < 2; ++n) _Pragma("unroll") for (int k = 0; k < 2; ++k) \
        acc[ai][bj][m][n] = __builtin_amdgcn_mfma_f32_16x16x32_bf16(Bt[n][k], At[m][k], acc[ai][bj][m][n], 0, 0, 0); __builtin_amdgcn_s_setprio(0); } while (0)
#define PG8_WAIT_V(n) asm volatile("s_waitcnt vmcnt(" #n ")" ::: "memory")
#define PG8_WAIT_L(n) asm volatile("s_waitcnt lgkmcnt(" #n ")" ::: "memory")
#define PG8_BAR __builtin_amdgcn_s_barrier()
#define PG8_SCHED __builtin_amdgcn_sched_barrier(0)
#define PG8_GOFF(dst, ord) do { _Pragma("unroll") for (int _h = 0; _h < 2; ++_h) _Pragma("unroll") for (int _i = 0; _i < 2; ++_i) \
        dst[_h][_i] = ((unsigned)itab[(ord) * BM + _h * HALF + RA[_i]] * (unsigned)K + (unsigned)CA[_i]) * 2u; } while (0)
    { int vals[4];
#pragma unroll
      for (int k = 0; k < 4; ++k) { const int e = tid + 512 * k; Unit uu; const bool ok = S.next(e >> 8, uu); vals[k] = ok ? gidx[uu.pm * BM + (e & 255)] : 0; }
#pragma unroll
      for (int k = 0; k < 4; ++k) itab[tid + 512 * k] = vals[k];
      asm volatile("s_waitcnt vmcnt(0) lgkmcnt(0)" ::: "memory"); __builtin_amdgcn_s_barrier(); asm volatile("" ::: "memory"); }
    Unit cur, nxt; int ui = 0;
    if (!S.next(0, cur)) return;
    f32x4 acc[2][2][4][2];
#pragma unroll
    for (int a = 0; a < 2; ++a)
#pragma unroll
        for (int b = 0; b < 2; ++b)
#pragma unroll
            for (int m = 0; m < 4; ++m)
#pragma unroll
                for (int n = 0; n < 2; ++n) acc[a][b][m][n] = (f32x4){0.f, 0.f, 0.f, 0.f};
    bf16x8 At[4][2], B0[2][2], B1[2][2];
    const char* const gA = (const char*)g.A;
    unsigned cvo[2][2], nvo[2][2];
    PG8_GOFF(cvo, 0);
    const char* cB = (const char*)g.Bt + (size_t)cur.pn * tstep;
    S.a_ready(cur);
    PG8_STAGE(PG8_SB(0, 0), cB, voffB); PG8_STAGE(PG8_SB(0, 1), cB + hstep, voffB); PG8_STAGE(PG8_SA(0, 0), gA, cvo[0]); PG8_STAGE(PG8_SA(0, 1), gA, cvo[1]);
    if (wr == 1) PG8_BAR;
    PG8_WAIT_V(2); PG8_BAR;
    PG8_STAGE(PG8_SB(1, 0), cB + kstep, voffB); PG8_STAGE(PG8_SA(1, 0), gA + kstep, cvo[0]); PG8_STAGE(PG8_SB(1, 1), cB + hstep + kstep, voffB);
    PG8_WAIT_V(6); PG8_BAR;
    for (;;) {
        const bool has_next = S.next(ui + 1, nxt);
        if (has_next) { PG8_GOFF(nvo, ui + 1); } else {
#pragma unroll
            for (int _h = 0; _h < 2; ++_h)
#pragma unroll
                for (int _i = 0; _i < 2; ++_i) nvo[_h][_i] = cvo[_h][_i]; }
        const char* nB = has_next ? (const char*)g.Bt + (size_t)nxt.pn * tstep : cB;
        for (int t = 0; t < nt; t += 2) {
            const bool last = (t == nt - 2);
            const char* a1 = gA + (size_t)(t + 1) * kstep;
            const char* a2 = last ? gA : gA + (size_t)(t + 2) * kstep; const char* b2 = last ? nB : cB + (size_t)(t + 2) * kstep;
            const char* a3 = a2 + kstep; const char* b3 = b2 + kstep;
            unsigned vo2[2][2];
#pragma unroll
            for (int _h = 0; _h < 2; ++_h)
#pragma unroll
                for (int _i = 0; _i < 2; ++_i) vo2[_h][_i] = last ? nvo[_h][_i] : cvo[_h][_i];
            if (last && has_next) S.a_ready(nxt);
            PG8_LDB(B0, 0, 0); PG8_LDB(B1, 0, 1); PG8_SCHED; PG8_LDA(At, 0, 0); PG8_STAGE(PG8_SA(1, 1), a1, cvo[1]);
            PG8_WAIT_V(8); PG8_WAIT_L(0); PG8_BAR; PG8_MMA(0, 0, At, B0); PG8_MMA(0, 1, At, B1); PG8_BAR; PG8_SCHED;
            PG8_LDA(At, 0, 1); PG8_STAGE(PG8_SB(0, 0), b2, voffB); PG8_STAGE(PG8_SB(0, 1), b2 + hstep, voffB); PG8_STAGE(PG8_SA(0, 0), a2, vo2[0]);
            PG8_WAIT_V(8); PG8_WAIT_L(0); PG8_BAR; PG8_MMA(1, 0, At, B0); PG8_MMA(1, 1, At, B1); PG8_BAR; PG8_SCHED;
            PG8_LDB(B0, 1, 0); PG8_LDB(B1, 1, 1); PG8_SCHED; PG8_LDA(At, 1, 0); PG8_STAGE(PG8_SA(0, 1), a2, vo2[1]);
            PG8_WAIT_V(8); PG8_WAIT_L(0); PG8_BAR; PG8_MMA(0, 0, At, B0); PG8_MMA(0, 1, At, B1); PG8_BAR; PG8_SCHED;
            PG8_LDA(At, 1, 1); PG8_STAGE(PG8_SB(1, 0), b3, voffB); PG8_STAGE(PG8_SB(1, 1), b3 + hstep, voffB); PG8_STAGE(PG8_SA(1, 0), a3, vo2[0]);
            PG8_WAIT_V(8); PG8_WAIT_L(0); PG8_BAR; PG8_MMA(1, 0, At, B0); PG8_MMA(1, 1, At, B1); PG8_BAR; PG8_SCHED;
        }
        if (wr == 0) PG8_BAR;
        E(acc, cur, wr, wc, fr, fq); S.done(cur);
        if (!has_next) break;
#pragma unroll
        for (int a = 0; a < 2; ++a)
#pragma unroll
            for (int b = 0; b < 2; ++b)
#pragma unroll
                for (int m = 0; m < 4; ++m)
#pragma unroll
                    for (int n = 0; n < 2; ++n) acc[a][b][m][n] = (f32x4){0.f, 0.f, 0.f, 0.f};
        cur = nxt; cB = nB; ++ui;
#pragma unroll
        for (int _h = 0; _h < 2; ++_h)
#pragma unroll
            for (int _i = 0; _i < 2; ++_i) cvo[_h][_i] = nvo[_h][_i];
        if (wr == 1) PG8_BAR;
    }
    PG8_WAIT_V(0);
    PG8_BAR;
#undef PG8_GOFF
#undef PG8_SA
#undef PG8_SB
#undef PG8_STAGE
#undef PG8_LDA
#undef PG8_LDB
#undef PG8_MMA
#undef PG8_WAIT_V
#undef PG8_WAIT_L
#undef PG8_BAR
#undef PG8_SCHED
}
}

constexpr int NB = 4, SEQ = 4096, D = 2048, CTXL = 256;
constexpr int M = NB * SEQ;
constexpr int MC = NB * CTXL;
constexpr int MT = M + MC;
constexpr int NHEAD = 32, HD = 64, NGRP = 4, NST = 128;
constexpr int XBCW = 3072;
constexpr int PROJ_COLS = 15424;
constexpr int NPROJ_TILES = 61;
constexpr int NPROJ = NPROJ_TILES * 256;
constexpr int NE = 16, FF = 2048, CAP = 512;
constexpr int MODW = 6 * D;
constexpr float EPS = 1e-6f;

#ifndef MK_N_LAUNCHES
#define MK_N_LAUNCHES 1
#endif
constexpr int NPHASES = 13;
constexpr int NCHUNK = MT / 128;
constexpr int XTCH = 2560;

constexpr size_t MiB = 1u << 20;
constexpr size_t WS_CTL = 0, CTL_ZERO_BYTES = 1 * MiB;
constexpr size_t WS_MODX = 1 * MiB;
constexpr size_t WS_MODC = WS_MODX + 256 * 1024;
constexpr size_t WS_AFF = 2 * MiB;
constexpr size_t WS_SLOT = 3 * MiB;
constexpr size_t WS_IDX = 4 * MiB;
constexpr size_t WS_VAL = 4 * MiB + 512 * 1024;
constexpr size_t WS_DTS = 11 * MiB;
constexpr size_t WS_WSSD = 16 * MiB, WS_WSC = 24 * MiB, WS_WO = 32 * MiB;
constexpr size_t WS_G = 40 * MiB;
constexpr size_t WS_ACT = 40 * MiB;
constexpr size_t WS_SCY = 168 * MiB;
constexpr size_t WS_Z = 232 * MiB;
constexpr size_t WS_HX2 = WS_Z;
constexpr size_t WS_XBC = 296 * MiB;
constexpr size_t WS_MERGED = 296 * MiB;
constexpr size_t WS_OUTE = 296 * MiB;
constexpr size_t WS_XBCR = 392 * MiB;
constexpr size_t WS_HX = 398 * MiB;
constexpr size_t WS_WIN = 466 * MiB;
constexpr size_t WS_HENT = 398 * MiB;
constexpr size_t WS_OUTX = 398 * MiB;
constexpr size_t WS_ST = 527 * MiB;
constexpr size_t WS_Y = 527 * MiB;
constexpr size_t WS_CHLOG = 5 * MiB;
constexpr size_t WS_W13 = 663 * MiB;
constexpr size_t WS_W2 = 919 * MiB;
constexpr size_t WS_END = 1047 * MiB;
constexpr int CW_BAR = 4096;
constexpr int CW_Q0 = 64, CW_Q1 = 128, CW_Q2 = 192, CW_Q3 = 256, CW_QG = 512  ;

constexpr int RING_BYTES = 131072;
constexpr int LDSCTL_OFF = 162816, MISC_OFF = LDSCTL_OFF + 320;
constexpr int LDS_BYTES = 163840;
constexpr int NWAVES = 8;

#define GAS __attribute__((address_space(1)))
#define LAS __attribute__((address_space(3)))
typedef unsigned short bf16;
typedef unsigned v4u __attribute__((ext_vector_type(4)));
typedef unsigned v2u __attribute__((ext_vector_type(2)));
typedef float f32x4 __attribute__((ext_vector_type(4)));
typedef float f32x16 __attribute__((ext_vector_type(16)));
typedef short bf16x8 __attribute__((ext_vector_type(8)));
#define LDS_WAIT() asm volatile("s_waitcnt lgkmcnt(0)" ::: "memory")
#define VM_WAIT() asm volatile("s_waitcnt vmcnt(0)" ::: "memory")
__device__ __forceinline__ unsigned pk2(float lo, float hi) { typedef float f2v __attribute__((ext_vector_type(2))); typedef __bf16 b2v __attribute__((ext_vector_type(2))); const f2v v = {lo, hi}; return __builtin_bit_cast(unsigned, __builtin_convertvector(v, b2v)); }
__device__ __forceinline__ float bflo(unsigned w) { return __builtin_bit_cast(float, w << 16); }
__device__ __forceinline__ float bfhi(unsigned w) { return __builtin_bit_cast(float, w & 0xffff0000u); }
__device__ __forceinline__ void unpack8(const v4u w, float (&o)[8]) { o[0] = bflo(w.x); o[1] = bfhi(w.x); o[2] = bflo(w.y); o[3] = bfhi(w.y); o[4] = bflo(w.z); o[5] = bfhi(w.z); o[6] = bflo(w.w); o[7] = bfhi(w.w); }
__device__ __forceinline__ v4u pack8(const float (&o)[8]) { v4u w; w.x = pk2(o[0], o[1]); w.y = pk2(o[2], o[3]); w.z = pk2(o[4], o[5]); w.w = pk2(o[6], o[7]); return w; }
__device__ __forceinline__ float siluf(float x) { return x * __builtin_amdgcn_rcpf(1.f + __expf(-x)); }
__device__ __forceinline__ float sigmf(float x) { return __builtin_amdgcn_rcpf(1.f + __expf(-x)); }
__device__ __forceinline__ float wave_sum(float v) {
#pragma unroll
    for (int o = 1; o < 64; o <<= 1) v += __shfl_xor(v, o);
    return v;
}

#define XB_TMO      128
#define XB_XCNT(j)  (256  + 64 * (j))
#define XB_XSUB(j)  (1280 + 64 * (j))
#define XB_XGEN(j)  (2304 + 64 * (j))
#define XB_TOP      3328
#define XB_TOPGEN   3392
#define XCD_BAR_WORDS 3456
#define XB_SPIN_CAP (1u << 18)

__device__ __forceinline__ unsigned xb_ld(unsigned* p)              { return __hip_atomic_load(p, __ATOMIC_RELAXED, __HIP_MEMORY_SCOPE_AGENT); }
__device__ __forceinline__ unsigned xb_add(unsigned* p, unsigned v) { return __hip_atomic_fetch_add(p, v, __ATOMIC_RELAXED, __HIP_MEMORY_SCOPE_AGENT); }
__device__ __forceinline__ unsigned xb_xcc_id() { return (unsigned)__builtin_amdgcn_s_getreg((3 << 11) | 20) & 0xFu; }
#define XB_SPIN(cond, bar) do { unsigned _sp = 0; while (cond) { __builtin_amdgcn_s_sleep(1); \
    if ((++_sp & 255u) == 0u) { if (xb_ld(&(bar)[XB_TMO])) break; if (_sp > XB_SPIN_CAP) { atomicAdd(&(bar)[XB_TMO], 1u); break; } } } } while (0)

struct XcdBarrier {
    unsigned* bar; unsigned x;
    volatile LAS unsigned* st;
};
__device__ __forceinline__ XcdBarrier xcd_barrier_post(unsigned* bar, volatile LAS unsigned* st) {
    XcdBarrier b; b.bar = bar; b.x = xb_xcc_id(); b.st = st;
    if (threadIdx.x == 0) (void)xb_add(&bar[XB_XCNT(b.x)], 1u);
    return b;
}
__device__ __forceinline__ void xcd_barrier_complete(unsigned* bar, unsigned x, unsigned& nloc, unsigned& nx) {
    const unsigned G = gridDim.x * gridDim.y * gridDim.z;
    unsigned sum, cnt, mine, sp = 0u;
    for (;;) {
        sum = 0u; cnt = 0u; mine = 0u;
#pragma unroll
        for (unsigned j = 0; j < 16; ++j) { const unsigned c = xb_ld(&bar[XB_XCNT(j)]); sum += c; cnt += (c > 0u) ? 1u : 0u; mine = (j == x) ? c : mine; }
        if (sum == G) break;
        __builtin_amdgcn_s_sleep(1);
        if ((++sp & 255u) == 0u) { if (xb_ld(&bar[XB_TMO])) break; if (sp > XB_SPIN_CAP) { atomicAdd(&bar[XB_TMO], 1u); break; } }
    }
    nloc = mine > 0u ? mine : 1u; nx = cnt > 0u ? cnt : 1u;
}
__device__ __forceinline__ void xcd_barrier(const XcdBarrier& b) {
    asm volatile("s_waitcnt vmcnt(0)" ::: "memory");
    __syncthreads();
    if (threadIdx.x == 0) {
        unsigned* bar = b.bar;
        __builtin_amdgcn_s_waitcnt(0);
        unsigned nloc = b.st[0], nx = b.st[1];
        if (nloc == 0u) { xcd_barrier_complete(bar, b.x, nloc, nx); b.st[0] = nloc; b.st[1] = nx; }
        const unsigned old = xb_add(&bar[XB_XSUB(b.x)], 1u);
        const unsigned gen = old / nloc;
        if (old + 1u == (gen + 1u) * nloc) {
            __builtin_amdgcn_fence(__ATOMIC_RELEASE, "agent");
            asm volatile("s_waitcnt vmcnt(0)" ::: "memory");
            const unsigned og = xb_add(&bar[XB_TOP], 1u);
            const unsigned tg = og / nx;
            if (og + 1u == (tg + 1u) * nx) xb_add(&bar[XB_TOPGEN], 1u);
            else XB_SPIN(xb_ld(&bar[XB_TOPGEN]) == tg, bar);
            __builtin_amdgcn_fence(__ATOMIC_ACQUIRE, "agent");
            xb_add(&bar[XB_XGEN(b.x)], 1u);
            asm volatile("s_waitcnt vmcnt(0)" ::: "memory");
        } else {
            XB_SPIN(xb_ld(&bar[XB_XGEN(b.x)]) == gen, bar);
            __builtin_amdgcn_fence(__ATOMIC_ACQUIRE, "agent");
            asm volatile("s_waitcnt vmcnt(0)" ::: "memory");
        }
    }
    __syncthreads();
}

struct WTile { const float* src; bf16* dst; const float* ksc; int ldw, ldk, perm; };
#define WTILE_STORE(T, v) do { \
    if ((T).ksc) { _Pragma("unroll") for (int j = 0; j < 16; ++j) v[j] = v[j] * (T).ksc[16 * kq + j]; } \
    const int drow_ = (T).perm ? 32 * (n4 >> 2) + 8 * (n4 & 3) : 4 * n4; \
    _Pragma("unroll") for (int q = 0; q < 4; ++q) { bf16* d = (T).dst + (size_t)(drow_ + q) * (T).ldk + 16 * kq; \
        v4u w0, w1; w0.x = pk2(v[0][q], v[1][q]); w0.y = pk2(v[2][q], v[3][q]); w0.z = pk2(v[4][q], v[5][q]); w0.w = pk2(v[6][q], v[7][q]); \
        w1.x = pk2(v[8][q], v[9][q]); w1.y = pk2(v[10][q], v[11][q]); w1.z = pk2(v[12][q], v[13][q]); w1.w = pk2(v[14][q], v[15][q]); \
        *(v4u*)d = w0; *(v4u*)(d + 8) = w1; } } while (0)
__device__ __forceinline__ void wtile_copy_pair(const WTile A, const WTile B, int lane) {
    const int n4 = lane & 15, kq = lane >> 4;
    f32x4 va[16], vb[16];
    { const float* s = A.src + (size_t)(16 * kq) * A.ldw + 4 * n4;
#pragma unroll
      for (int j = 0; j < 16; ++j) va[j] = __builtin_nontemporal_load((const f32x4*)(s + (size_t)j * A.ldw)); }
    { const float* s = B.src + (size_t)(16 * kq) * B.ldw + 4 * n4;
#pragma unroll
      for (int j = 0; j < 16; ++j) vb[j] = __builtin_nontemporal_load((const f32x4*)(s + (size_t)j * B.ldw)); }
    WTILE_STORE(A, va); WTILE_STORE(B, vb);
}
struct ExpertCopy { const float* w_e1; const float* w_e3; const float* w_e2; bf16* W13; bf16* W2; };
__device__ __forceinline__ WTile expert_tile_addr(const ExpertCopy& X, int it) {
    constexpr int I_SQ = 32 * 32;
    const int e = it / (3 * I_SQ); int r = it % (3 * I_SQ); const int which = r / I_SQ; r %= I_SQ; const int kb = r / 32, nb = r % 32, n0 = nb * 64, k0 = kb * 64;
    WTile t; t.ksc = nullptr; t.perm = 0;
    if (which == 0) { t.src = X.w_e1 + (size_t)e * D * FF + (size_t)k0 * FF + n0; t.ldw = FF; t.dst = X.W13 + (size_t)(e * 4096 + 256 * (n0 / 128) + (n0 % 128)) * D + k0; t.ldk = D; }
    else if (which == 1) { t.src = X.w_e3 + (size_t)e * D * FF + (size_t)k0 * FF + n0; t.ldw = FF; t.dst = X.W13 + (size_t)(e * 4096 + 256 * (n0 / 128) + 128 + (n0 % 128)) * D + k0; t.ldk = D; }
    else { t.src = X.w_e2 + (size_t)e * FF * D + (size_t)k0 * D + n0; t.ldw = D; t.dst = X.W2 + (size_t)(e * 2048 + n0) * FF + k0; t.ldk = FF; }
    return t;
}
#define WTILE_LOAD(T, v) do { const float* s_ = (T).src + (size_t)(16 * kq) * (T).ldw + 4 * n4; \
    _Pragma("unroll") for (int j = 0; j < 16; ++j) v[j] = __builtin_nontemporal_load((const f32x4*)(s_ + (size_t)j * (T).ldw)); } while (0)
__device__ __forceinline__ void expert_copy_share(const ExpertCopy& X, unsigned* qhead, int lane) {
    constexpr int NIT = NE * 3 * 32 * 32, GRP = 16;
    static_assert(FF == D && NIT % GRP == 0 && 32 % GRP == 0, "group addressing");
    const int n4 = lane & 15, kq = lane >> 4;
#pragma unroll 1
    for (;;) { int g0 = 0; if (lane == 0) g0 = (int)__hip_atomic_fetch_add(qhead, (unsigned)GRP, __ATOMIC_RELAXED, __HIP_MEMORY_SCOPE_AGENT);
        g0 = __builtin_amdgcn_readfirstlane(g0); if (g0 >= NIT) break;
        const WTile t0 = expert_tile_addr(X, g0); const bool w13 = (g0 / (32 * 32)) % 3 != 2;
        f32x4 va[16], vb[16];
        WTile ta = t0, tb = t0; tb.src = t0.src + 64; tb.dst = t0.dst + (size_t)64 * D;
        WTILE_LOAD(ta, va); WTILE_LOAD(tb, vb);
#pragma unroll
        for (int k = 0; k < GRP; k += 2) {
            __builtin_amdgcn_sched_barrier(0);
            WTILE_STORE(ta, va);
            if (k + 2 < GRP) { ta.src = t0.src + 64 * (k + 2); ta.dst = t0.dst + (size_t)(w13 ? 256 * ((k + 2) >> 1) : 64 * (k + 2)) * D; WTILE_LOAD(ta, va); }
            __builtin_amdgcn_sched_barrier(0);
            WTILE_STORE(tb, vb);
            if (k + 3 < GRP) { tb.src = t0.src + 64 * (k + 3); tb.dst = t0.dst + (size_t)(w13 ? 256 * ((k + 3) >> 1) + 64 : 64 * (k + 3)) * D; WTILE_LOAD(tb, vb); }
        }
    }
}
struct MixerCopy { const float* w_in; const float* w_ssd_out; const float* w_sc_out; const float* w_o; const float* ssd_norm_w; bf16* WIN; bf16* WSSD; bf16* WSC; bf16* WO; };
__device__ __forceinline__ WTile mixer_tile_addr(const MixerCopy& X, int it) {
    constexpr int I_IN = 32 * (PROJ_COLS / 64), I_SQ = 32 * 32;
    WTile t; t.ksc = nullptr; t.perm = 0;
    if (it < I_IN) { const int kb = it / (PROJ_COLS / 64), nb = it % (PROJ_COLS / 64), n0 = nb * 64, k0 = kb * 64; int vrow;
        if (n0 < 2048) { vrow = (12 + n0 / 64) * 256 + 128 + 4; t.perm = 1; }
        else if (n0 < 5120) vrow = n0 - 2048;
        else if (n0 < 5184) vrow = 60 * 256 + (n0 - 5120);
        else if (n0 < 7232) { vrow = (12 + (n0 - 5184) / 64) * 256; t.perm = 1; }
        else if (n0 < 9280) { vrow = (12 + (n0 - 7232) / 64) * 256 + 4; t.perm = 1; }
        else if (n0 < 11328) { vrow = (12 + (n0 - 9280) / 64) * 256 + 128; t.perm = 1; }
        else vrow = 44 * 256 + (n0 - 11328);
        t.src = X.w_in + (size_t)k0 * PROJ_COLS + n0; t.ldw = PROJ_COLS; t.dst = X.WIN + (size_t)vrow * D + k0; t.ldk = D; return t; }
    int r = it - I_IN; const int which = r / I_SQ; r %= I_SQ; const int kb = r / 32, nb = r % 32, n0 = nb * 64, k0 = kb * 64;
    const size_t so = (size_t)k0 * D + n0, dof = (size_t)n0 * D + k0; t.ldw = D; t.ldk = D;
    if (which == 0) { t.src = X.w_ssd_out + so; t.dst = X.WSSD + dof; t.ksc = X.ssd_norm_w + k0; }
    else if (which == 1) { t.src = X.w_sc_out + so; t.dst = X.WSC + dof; }
    else { t.src = X.w_o + so; t.dst = X.WO + dof; }
    return t;
}
struct OrderProj {
    static constexpr bool DYNAMIC = false;
    pg8::StaticOrder so; int G, c;
    __device__ __forceinline__ void init(int G_, int c_) { G = G_; c = c_; so.init(M, NPROJ, G_, c_); }
    __device__ __forceinline__ bool next(int i, pg8::Unit& u) const {
        const int L = i * G + c;
        if (L < 64 * NPROJ_TILES) return so.next(i, u);
        const int j = L - 64 * NPROJ_TILES; if (j >= 4 * 13) return false;
        u.pm = 64 + j / 13; const int k = j % 13; u.pn = k < 12 ? k : 60; return true;
    }
    __device__ __forceinline__ void a_ready(const pg8::Unit&) const {}
    __device__ __forceinline__ void done(const pg8::Unit&) const {}
};
struct OrderProjDyn {
    static constexpr bool DYNAMIC = true;
    unsigned* q; volatile LAS unsigned* slot; int x;
    __device__ __forceinline__ void init(unsigned* q0, volatile LAS unsigned* slot_, int c) { x = c & 7; q = q0 + 64 * x; slot = slot_;
        __syncthreads();
        if (threadIdx.x == 0) { const unsigned k = __hip_atomic_fetch_add(q, 2u, __ATOMIC_RELAXED, __HIP_MEMORY_SCOPE_AGENT); slot[0] = k; slot[1] = k + 1u; }
        __syncthreads(); }
    __device__ __forceinline__ bool next(int i, pg8::Unit& u) const {
        constexpr int QX = 64 * NPROJ_TILES / 8;
        const int k = __builtin_amdgcn_readfirstlane((int)slot[i & 3]);
        if (k < QX) { u.pm = 8 * x + (k & 7); u.pn = k >> 3; return true; }
        const int j = (k - QX) * 8 + x; if (j >= 4 * 13) return false;
        u.pm = 64 + j / 13; const int kk = j % 13; u.pn = kk < 12 ? kk : 60; return true;
    }
    __device__ __forceinline__ unsigned claim_issue(int wid, int lane) const { unsigned r = 0u; if (wid == 0 && lane == 0) { unsigned z; asm volatile("v_mov_b32 %0, 0" : "=v"(z)); r = __hip_atomic_fetch_add(q + z, 1u, __ATOMIC_RELAXED, __HIP_MEMORY_SCOPE_AGENT); } return r; }
    __device__ __forceinline__ void claim_publish(int i, unsigned r, int wid, int lane) const { const unsigned rr = __builtin_amdgcn_readfirstlane(r); if (lane == 0) slot[wid == 0 ? (i & 3) : 4 + wid] = rr; asm volatile("s_waitcnt lgkmcnt(0)" ::: "memory"); }
    __device__ __forceinline__ void a_ready(const pg8::Unit&) const {}
    __device__ __forceinline__ void done(const pg8::Unit&) const {}
};
template <int NJ> struct OrderMoe {
    static constexpr bool DYNAMIC = false;
    int G, c;
    __device__ __forceinline__ void init(int G_, int c_) { G = G_; c = c_; }
    __device__ __forceinline__ bool next(int i, pg8::Unit& u) const {
        constexpr int NWG = NE * 8 * NJ, Q = NWG / 8;
        const int L = i * G + c; if (L >= NWG) return false;
        const int wgid = (L % 8) * Q + L / 8;
        const int e = wgid / (8 * NJ), w = wgid % (8 * NJ), rt = w % 8, j = w / 8, b = rt >> 1, half = rt & 1;
        u.pm = (b * NE + e) * 2 + half; u.pn = e * NJ + j; return true;
    }
    __device__ __forceinline__ void a_ready(const pg8::Unit&) const {}
    __device__ __forceinline__ void done(const pg8::Unit&) const {}
};

struct OrderTwice {
    static constexpr bool DYNAMIC = false;
    pg8::StaticOrder so; int R;
    __device__ __forceinline__ bool next(int i, pg8::Unit& u) const { const int s = i >= R ? 1 : 0; const bool ok = so.next(i - s * R, u); u.sel = s; return ok && i < 2 * R; }
    __device__ __forceinline__ void a_ready(const pg8::Unit&) const {}
    __device__ __forceinline__ void done(const pg8::Unit&) const {}
};
using pg8::f32x4;
using pg8::u32x4;
__device__ __forceinline__ float softplusf(float x) { return x > 20.f ? x : log1pf(expf(x)); }
__device__ __forceinline__ float dpp_ror1(float v) { return __builtin_bit_cast(float, __builtin_amdgcn_update_dpp(0, __builtin_bit_cast(int, v), 0x121, 0xf, 0xf, false)); }
__device__ __forceinline__ float dpp_ror15(float v) { return __builtin_bit_cast(float, __builtin_amdgcn_update_dpp(0, __builtin_bit_cast(int, v), 0x12F, 0xf, 0xf, false)); }
struct EpiProj {
    static constexpr bool PERM = true, AFTER_DRAIN = false;
    bf16 *Z, *XBC, *XBCR, *SCY, *Gt; float* DTS; const float *cw, *cb, *scw, *dtb;
    __device__ __forceinline__ void operator()(const f32x4 (&acc)[2][2][4][2], const pg8::Unit& u, int wr, int wc, int fr, int fq_in) const {
        int fq = fq_in; asm volatile("" : "+v"(fq));
        const int row0 = u.pm * 256 + wr * 64 + fr; const int pn = u.pn;
        if (pn < 12) {
            const int col0 = pn * 256 + wc * 32 + 8 * fq;
            if (u.pm >= 64) {
#pragma unroll
                for (int ai = 0; ai < 2; ++ai)
#pragma unroll
                    for (int m = 0; m < 4; ++m) { bf16* rowp = XBCR + (size_t)(row0 - M + ai * 128 + m * 16) * XBCW + col0;
#pragma unroll
                        for (int bj = 0; bj < 2; ++bj) { const f32x4 v0 = acc[ai][bj][m][0], v1 = acc[ai][bj][m][1];
                            u32x4 w; w.x = pg8::cvt_pk_bf16(v0[0], v0[1]); w.y = pg8::cvt_pk_bf16(v0[2], v0[3]); w.z = pg8::cvt_pk_bf16(v1[0], v1[1]); w.w = pg8::cvt_pk_bf16(v1[2], v1[3]);
                            *(u32x4*)(rowp + bj * 128) = w; } }
            } else {
#pragma unroll
                for (int bj = 0; bj < 2; ++bj) {
                    const int col = col0 + bj * 128;
                    f32x4 w0[2], w1[2], w2[2], bb[2];
#pragma unroll
                    for (int n = 0; n < 2; ++n) { w0[n] = *(const f32x4*)(cw + col + 4 * n); w1[n] = *(const f32x4*)(cw + XBCW + col + 4 * n); w2[n] = *(const f32x4*)(cw + 2 * XBCW + col + 4 * n); bb[n] = *(const f32x4*)(cb + col + 4 * n); }
#pragma unroll
                    for (int ai = 0; ai < 2; ++ai) {
                        f32x4 o[4][2];
#pragma unroll
                        for (int n = 0; n < 2; ++n)
#pragma unroll
                            for (int q = 0; q < 4; ++q) { float A[4], B[4];
#pragma unroll
                                for (int m = 0; m < 4; ++m) { A[m] = dpp_ror1(acc[ai][bj][m][n][q]); B[m] = dpp_ror15(acc[ai][bj][m][n][q]); }
#pragma unroll
                                for (int m = 0; m < 4; ++m) { const float pv = fr > 0 ? A[m] : (m > 0 ? A[m > 0 ? m - 1 : 0] : 0.f), nv = fr < 15 ? B[m] : (m < 3 ? B[m < 3 ? m + 1 : 3] : 0.f);
                                    o[m][n][q] = siluf(bb[n][q] + w0[n][q] * pv + w1[n][q] * acc[ai][bj][m][n][q] + w2[n][q] * nv); } }
#pragma unroll
                        for (int m = 0; m < 4; ++m) { u32x4 w; w.x = pg8::cvt_pk_bf16(o[m][0][0], o[m][0][1]); w.y = pg8::cvt_pk_bf16(o[m][0][2], o[m][0][3]); w.z = pg8::cvt_pk_bf16(o[m][1][0], o[m][1][1]); w.w = pg8::cvt_pk_bf16(o[m][1][2], o[m][1][3]);
                            *(u32x4*)(XBC + (size_t)(row0 + ai * 128 + m * 16) * XBCW + col) = w; }
                    }
                }
            }
        } else if (pn < 44) {
            const int ch = (pn - 12) * 64 + wc * 16 + 4 * fq;
            const f32x4 w0 = *(const f32x4*)(scw + ch), w1 = *(const f32x4*)(scw + D + ch), w2 = *(const f32x4*)(scw + 2 * D + ch);
#pragma unroll
            for (int ai = 0; ai < 2; ++ai) {
                f32x4 cv[4];
#pragma unroll
                for (int m = 0; m < 4; ++m) cv[m] = acc[ai][0][m][1] * acc[ai][1][m][0];
                f32x4 o[4];
#pragma unroll
                for (int q = 0; q < 4; ++q) { float A[4], B[4];
#pragma unroll
                    for (int m = 0; m < 4; ++m) { A[m] = dpp_ror1(cv[m][q]); B[m] = dpp_ror15(cv[m][q]); }
#pragma unroll
                    for (int m = 0; m < 4; ++m) { const float pv = fr > 0 ? A[m] : (m > 0 ? A[m > 0 ? m - 1 : 0] : 0.f), nv = fr < 15 ? B[m] : (m < 3 ? B[m < 3 ? m + 1 : 3] : 0.f);
                        o[m][q] = acc[ai][0][m][0][q] * (w0[q] * pv + w1[q] * cv[m][q] + w2[q] * nv); } }
#pragma unroll
                for (int m = 0; m < 4; ++m) { const size_t row = (size_t)(row0 + ai * 128 + m * 16); const f32x4 zz = acc[ai][1][m][1];
                    v2u ws_; ws_.x = pg8::cvt_pk_bf16(o[m][0], o[m][1]); ws_.y = pg8::cvt_pk_bf16(o[m][2], o[m][3]); *(v2u*)(SCY + row * D + ch) = ws_;
                    v2u wz; wz.x = pg8::cvt_pk_bf16(zz[0], zz[1]); wz.y = pg8::cvt_pk_bf16(zz[2], zz[3]); *(v2u*)(Z + row * D + ch) = wz; }
            }
        } else if (pn < 60) {
            const int col0 = (pn - 44) * 256 + wc * 32 + 8 * fq;
#pragma unroll
            for (int ai = 0; ai < 2; ++ai)
#pragma unroll
                for (int m = 0; m < 4; ++m) { bf16* rowp = Gt + (size_t)(row0 + ai * 128 + m * 16) * (2 * D) + col0;
#pragma unroll
                    for (int bj = 0; bj < 2; ++bj) { const f32x4 v0 = acc[ai][bj][m][0], v1 = acc[ai][bj][m][1];
                        u32x4 w; w.x = pg8::cvt_pk_bf16(v0[0], v0[1]); w.y = pg8::cvt_pk_bf16(v0[2], v0[3]); w.z = pg8::cvt_pk_bf16(v1[0], v1[1]); w.w = pg8::cvt_pk_bf16(v1[2], v1[3]);
                        *(u32x4*)(rowp + bj * 128) = w; } }
        } else {
            if (wc < 2) {
                const int col0 = wc * 32 + 8 * fq; const f32x4 b0 = *(const f32x4*)(dtb + col0), b1 = *(const f32x4*)(dtb + col0 + 4);
#pragma unroll
                for (int ai = 0; ai < 2; ++ai)
#pragma unroll
                    for (int m = 0; m < 4; ++m) { float* rowp = DTS + (size_t)(row0 + ai * 128 + m * 16) * 64 + col0; f32x4 o0, o1;
#pragma unroll
                        for (int q = 0; q < 4; ++q) { o0[q] = softplusf(acc[ai][0][m][0][q] + b0[q]); o1[q] = softplusf(acc[ai][0][m][1][q] + b1[q]); }
                        *(f32x4*)(rowp) = o0; *(f32x4*)(rowp + 4) = o1; }
            }
        }
    }
};
struct EpiBf16Plain {
    static constexpr bool PERM = true, AFTER_DRAIN = false;
    bf16* O; int ldc;
    __device__ __forceinline__ void operator()(const f32x4 (&acc)[2][2][4][2], const pg8::Unit& u, int wr, int wc, int fr, int fq) const {
        const int row0 = u.pm * 256 + wr * 64 + fr, col0 = u.pn * 256 + wc * 32 + 8 * fq;
#pragma unroll
        for (int ai = 0; ai < 2; ++ai)
#pragma unroll
            for (int m = 0; m < 4; ++m) { bf16* rowp = O + (size_t)(row0 + ai * 128 + m * 16) * ldc + col0;
#pragma unroll
                for (int bj = 0; bj < 2; ++bj) { const f32x4 v0 = acc[ai][bj][m][0], v1 = acc[ai][bj][m][1];
                    u32x4 w; w.x = pg8::cvt_pk_bf16(v0[0], v0[1]); w.y = pg8::cvt_pk_bf16(v0[2], v0[3]); w.z = pg8::cvt_pk_bf16(v1[0], v1[1]); w.w = pg8::cvt_pk_bf16(v1[2], v1[3]);
                    *(u32x4*)(rowp + bj * 128) = w; } }
    }
};
struct EpiGate {
    static constexpr bool PERM = true, AFTER_DRAIN = false;
    const bf16* Gt; const float* bg; bf16* O;
    __device__ __forceinline__ void operator()(const f32x4 (&acc)[2][2][4][2], const pg8::Unit& u, int wr, int wc, int fr, int fq_in) const {
        int fq = fq_in; asm volatile("" : "+v"(fq));
        const int row0 = u.pm * 256 + wr * 64 + fr, col0 = u.pn * 256 + wc * 32 + 8 * fq; const bool first = u.sel == 0; const int goff = first ? 0 : D;
#pragma unroll
        for (int bj = 0; bj < 2; ++bj) {
            const int col = col0 + bj * 128;
            float b0[8];
            { const f32x4 t0 = *(const f32x4*)(bg + goff + col), t1 = *(const f32x4*)(bg + goff + col + 4);
#pragma unroll
              for (int q = 0; q < 4; ++q) { b0[q] = t0[q]; b0[4 + q] = t1[q]; } }
#pragma unroll
            for (int ai = 0; ai < 2; ++ai) {
                v4u gw_[4], pw_[4];
#pragma unroll
                for (int m = 0; m < 4; ++m) { const size_t row = (size_t)(row0 + ai * 128 + m * 16);
                    gw_[m] = *(const v4u*)(Gt + row * (2 * D) + goff + col); pw_[m] = first ? (v4u){0u, 0u, 0u, 0u} : *(const v4u*)(O + row * D + col); }
                __builtin_amdgcn_sched_barrier(0);
#pragma unroll
                for (int m = 0; m < 4; ++m) { const size_t row = (size_t)(row0 + ai * 128 + m * 16);
                    float g0[8], p[8]; unpack8(gw_[m], g0); unpack8(pw_[m], p);
                    float o[8];
#pragma unroll
                    for (int q = 0; q < 4; ++q) { o[q] = p[q] + sigmf(g0[q] + b0[q]) * acc[ai][bj][m][0][q]; o[4 + q] = p[4 + q] + sigmf(g0[4 + q] + b0[4 + q]) * acc[ai][bj][m][1][q]; }
                    *(v4u*)(O + row * D + col) = pack8(o); }
            }
        }
    }
};
struct EpiMoe1 {
    static constexpr bool PERM = true, AFTER_DRAIN = false;
    bf16* ACT;
    __device__ __forceinline__ void operator()(const f32x4 (&acc)[2][2][4][2], const pg8::Unit& u, int wr, int wc, int fr, int fq) const {
        const int row0 = u.pm * 256 + wr * 64 + fr, col0 = (u.pn & 15) * 128 + wc * 32 + 8 * fq;
#pragma unroll
        for (int ai = 0; ai < 2; ++ai)
#pragma unroll
            for (int m = 0; m < 4; ++m) { float o[8];
#pragma unroll
                for (int q = 0; q < 4; ++q) { o[q] = siluf(acc[ai][0][m][0][q]) * acc[ai][1][m][0][q]; o[4 + q] = siluf(acc[ai][0][m][1][q]) * acc[ai][1][m][1][q]; }
                *(v4u*)(ACT + (size_t)(row0 + ai * 128 + m * 16) * FF + col0) = pack8(o); }
    }
};
struct EpiMoe2 {
    static constexpr bool PERM = true, AFTER_DRAIN = false;
    bf16* O; const float* VAL;
    __device__ __forceinline__ void operator()(const f32x4 (&acc)[2][2][4][2], const pg8::Unit& u, int wr, int wc, int fr, int fq) const {
        const int row0 = u.pm * 256 + wr * 64 + fr, col0 = (u.pn & 7) * 256 + wc * 32 + 8 * fq;
        float sv[2][4];
#pragma unroll
        for (int ai = 0; ai < 2; ++ai)
#pragma unroll
            for (int m = 0; m < 4; ++m) sv[ai][m] = VAL[row0 + ai * 128 + m * 16];
#pragma unroll
        for (int ai = 0; ai < 2; ++ai)
#pragma unroll
            for (int m = 0; m < 4; ++m) { const int row = row0 + ai * 128 + m * 16; const float s = sv[ai][m]; bf16* rowp = O + (size_t)row * D + col0;
#pragma unroll
                for (int bj = 0; bj < 2; ++bj) { const f32x4 v0 = acc[ai][bj][m][0] * s, v1 = acc[ai][bj][m][1] * s;
                    v4u w; w.x = pk2(v0[0], v0[1]); w.y = pk2(v0[2], v0[3]); w.z = pk2(v1[0], v1[1]); w.w = pk2(v1[2], v1[3]);
                    *(v4u*)(rowp + bj * 128) = w; } }
    }
};

__device__ __forceinline__ v4u conv8r(const v4u cur, const v4u prv, const v4u nxt, const float* __restrict__ cw, const float* __restrict__ cb, int ch) {
    float c[8], p[8], n[8], o[8]; unpack8(cur, c); unpack8(prv, p); unpack8(nxt, n);
#pragma unroll
    for (int h4 = 0; h4 < 2; ++h4) { const f32x4 w0 = *(const f32x4*)(cw + ch + 4 * h4), w1 = *(const f32x4*)(cw + XBCW + ch + 4 * h4), w2 = *(const f32x4*)(cw + 2 * XBCW + ch + 4 * h4), bb = *(const f32x4*)(cb + ch + 4 * h4);
#pragma unroll
        for (int q = 0; q < 4; ++q) o[4 * h4 + q] = siluf(bb[q] + w0[q] * p[4 * h4 + q] + w1[q] * c[4 * h4 + q] + w2[q] * n[4 * h4 + q]); }
    return pack8(o);
}
__device__ __forceinline__ v4u conv8c(const bf16* __restrict__ XBCR, const float* __restrict__ cw, const float* __restrict__ cb, int rc, int ch) {
    const int pos = rc & 255; const bool hp = pos > 0, hn = pos < 255;
    const bf16* p = XBCR + (size_t)rc * XBCW + ch;
    const v4u cur = *(const v4u*)p; v4u prv = *(const v4u*)(hp ? p - XBCW : p), nxt = *(const v4u*)(hn ? p + XBCW : p);
    prv.x = hp ? prv.x : 0u; prv.y = hp ? prv.y : 0u; prv.z = hp ? prv.z : 0u; prv.w = hp ? prv.w : 0u;
    nxt.x = hn ? nxt.x : 0u; nxt.y = hn ? nxt.y : 0u; nxt.z = hn ? nxt.z : 0u; nxt.w = hn ? nxt.w : 0u;
    return conv8r(cur, prv, nxt, cw, cb, ch);
}
typedef short v4i16_t __attribute__((ext_vector_type(4)));
__device__ __forceinline__ v2u tr_read(const LAS unsigned char* p) { return __builtin_bit_cast(v2u, __builtin_amdgcn_ds_read_tr16_b64_v4i16((LAS v4i16_t*)p)); }

__device__ __forceinline__ int claim_item(unsigned* qhead, volatile LAS unsigned* slot) {
    __syncthreads();
    if (threadIdx.x == 0) *slot = __hip_atomic_fetch_add(qhead, 1u, __ATOMIC_RELAXED, __HIP_MEMORY_SCOPE_AGENT);
    __syncthreads();
    return (int)*slot;
}
struct Args { const float* in[26]; float* out; unsigned char* ws; int ph_lo, ph_hi; };
static_assert(sizeof(Args) == 26 * 8 + 8 + 8 + 8, "Args has no padding");

__global__ void __launch_bounds__(NWAVES * 64, 2) mk_fwd(Args args) {
    extern __shared__ __attribute__((aligned(16))) unsigned char lds_raw[];
    LAS unsigned char* lds = (LAS unsigned char*)lds_raw;
    volatile LAS unsigned* MISC = (volatile LAS unsigned*)(lds + MISC_OFF);
    const int tid = threadIdx.x, lane = tid & 63, wave = __builtin_amdgcn_readfirstlane(tid >> 6);
    const int G = gridDim.x, bx = blockIdx.x;
    const int gw = bx * NWAVES + wave, NGW = G * NWAVES;
    const size_t gtid = (size_t)bx * (NWAVES * 64) + tid, NGT = (size_t)G * (NWAVES * 64);
    unsigned* ctl = (unsigned*)(args.ws + WS_CTL);

#define KAS __attribute__((address_space(4)))
#define PHASE_BASES() const KAS char* KA = (const KAS char*)__builtin_amdgcn_kernarg_segment_ptr(); asm volatile("" : "+s"(KA)); unsigned char* const ws = *(unsigned char* const KAS*)(KA + 8 * 27)
#define KARG(k) (*(const float* const KAS*)(KA + 8 * (k)))
#define in_x KARG(0)
#define cvec KARG(1)
#define ctx KARG(2)
#define c_ctx KARG(3)
#define w_mod KARG(4)
#define b_mod KARG(5)
#define n_pre_mix KARG(6)
#define n_post_mix KARG(7)
#define w_in KARG(8)
#define ssd_conv_w KARG(9)
#define ssd_conv_b KARG(10)
#define dt_bias KARG(11)
#define a_log KARG(12)
#define ssd_d KARG(13)
#define ssd_norm_w KARG(14)
#define w_ssd_out KARG(15)
#define sc_conv_w KARG(16)
#define w_sc_out KARG(17)
#define b_gate KARG(18)
#define w_o KARG(19)
#define n_pre_ffn KARG(20)
#define n_post_ffn KARG(21)
#define w_router KARG(22)
#define w_e1 KARG(23)
#define w_e3 KARG(24)
#define w_e2 KARG(25)
#define out (*(float* const KAS*)(KA + 8 * 26))
#define MODX ((float*)(ws + WS_MODX))
#define MODC ((float*)(ws + WS_MODC))
#define AFF ((float*)(ws + WS_AFF))
#define SLOT ((int*)(ws + WS_SLOT))
#define IDX ((int*)(ws + WS_IDX))
#define VAL ((float*)(ws + WS_VAL))
#define DTS ((float*)(ws + WS_DTS))
#define WIN ((bf16*)(ws + WS_WIN))
#define WSSD ((bf16*)(ws + WS_WSSD))
#define WSC ((bf16*)(ws + WS_WSC))
#define WO ((bf16*)(ws + WS_WO))
#define HX ((bf16*)(ws + WS_HX))
#define Zb ((bf16*)(ws + WS_Z))
#define XBC ((bf16*)(ws + WS_XBC))
#define XBCR ((bf16*)(ws + WS_XBCR))
#define Gt ((bf16*)(ws + WS_G))
#define SCY ((bf16*)(ws + WS_SCY))
#define ST ((bf16*)(ws + WS_ST))
#define HENT ((bf16*)(ws + WS_HENT))
#define CHLOG ((float*)(ws + WS_CHLOG))
#define Yn ((bf16*)(ws + WS_Y))
#define MERGED ((bf16*)(ws + WS_MERGED))
#define OUTX ((bf16*)(ws + WS_OUTX))
#define HX2 ((bf16*)(ws + WS_HX2))
#define W13 ((bf16*)(ws + WS_W13))
#define W2 ((bf16*)(ws + WS_W2))
#define ACT ((bf16*)(ws + WS_ACT))
#define OUTE ((bf16*)(ws + WS_OUTE))
    for (int u = tid; u < (LDS_BYTES - LDSCTL_OFF) / 4; u += NWAVES * 64) ((LAS unsigned*)(lds + LDSCTL_OFF))[u] = 0u;
    __syncthreads();
    XcdBarrier bar; bar.bar = ctl + CW_BAR; bar.x = 0; bar.st = nullptr;
    if (MK_N_LAUNCHES == 1) bar = xcd_barrier_post(ctl + CW_BAR, MISC + 8);
#define GRID_BAR() do { if (MK_N_LAUNCHES == 1) xcd_barrier(bar); } while (0)
    const int lo = args.ph_lo, hi = args.ph_hi;
#ifndef PH_MASK
#define PH_MASK 0xFFFFFFFFu
#endif
#define IN(k) (((PH_MASK >> (k)) & 1u) && lo <= (k) && (k) < hi)
#define BOTH(k) (IN(k) && IN((k) + 1))

    if (IN(0)) { PHASE_BASES();
        for (int bi = bx; bi < MODW / 128; bi += G) {
            LAS float* sl = (LAS float*)lds;
            LAS float* red = (LAS float*)(lds + 5 * 2048 * 4);
            for (int i = tid; i < 5 * D; i += NWAVES * 64) { const int r = i / D, k = i % D; const float v = r < 4 ? cvec[r * D + k] : c_ctx[k]; sl[i] = siluf(v); }
            __syncthreads();
            const int c4 = lane & 31, kh = lane >> 5;
            f32x4 a0 = {0.f, 0.f, 0.f, 0.f}, a1 = a0, a2 = a0, a3 = a0, a4 = a0;
            const float* wp = w_mod + (size_t)(wave * 256 + kh) * MODW + bi * 128 + 4 * c4;
#pragma unroll 8
            for (int kk = 0; kk < 128; ++kk) { const f32x4 wv = *(const f32x4*)(wp + (size_t)(2 * kk) * MODW); const int k = wave * 256 + 2 * kk + kh;
                a0 += wv * sl[k]; a1 += wv * sl[D + k]; a2 += wv * sl[2 * D + k]; a3 += wv * sl[3 * D + k]; a4 += wv * sl[4 * D + k]; }
#pragma unroll
            for (int q = 0; q < 4; ++q) { a0[q] += __shfl_xor(a0[q], 32); a1[q] += __shfl_xor(a1[q], 32); a2[q] += __shfl_xor(a2[q], 32); a3[q] += __shfl_xor(a3[q], 32); a4[q] += __shfl_xor(a4[q], 32); }
            if (kh == 0) { *(LAS f32x4*)(red + (wave * 5 + 0) * 128 + 4 * c4) = a0; *(LAS f32x4*)(red + (wave * 5 + 1) * 128 + 4 * c4) = a1; *(LAS f32x4*)(red + (wave * 5 + 2) * 128 + 4 * c4) = a2;
                           *(LAS f32x4*)(red + (wave * 5 + 3) * 128 + 4 * c4) = a3; *(LAS f32x4*)(red + (wave * 5 + 4) * 128 + 4 * c4) = a4; }
            __syncthreads();
            for (int i = tid; i < 5 * 128; i += NWAVES * 64) { const int r = i >> 7, l = i & 127; float sacc = 0.f;
#pragma unroll
                for (int w = 0; w < 8; ++w) sacc += red[(w * 5 + r) * 128 + l];
                const int cc = bi * 128 + l; sacc += b_mod[cc]; if (r < 4) MODX[r * MODW + cc] = sacc; else MODC[cc] = sacc; }
            __syncthreads();
        }
        { constexpr int NIT = 32 * (PROJ_COLS / 64) + 3 * 32 * 32;
          const MixerCopy X{w_in, w_ssd_out, w_sc_out, w_o, ssd_norm_w, WIN, WSSD, WSC, WO};
#pragma unroll 1
          for (;;) { int g0 = 0; if (lane == 0) g0 = (int)__hip_atomic_fetch_add(ctl + CW_Q0, 8u, __ATOMIC_RELAXED, __HIP_MEMORY_SCOPE_AGENT);
              g0 = __builtin_amdgcn_readfirstlane(g0); if (g0 >= NIT) break;
#pragma unroll 1
              for (int k = 0; k < 8; k += 2) wtile_copy_pair(mixer_tile_addr(X, g0 + k), mixer_tile_addr(X, g0 + k + 1), lane); } }
        { v4u* zp = (v4u*)(WIN + (size_t)15424 * D); const size_t nz = (size_t)192 * D * 2 / 16; for (size_t i = gtid; i < nz; i += NGT) zp[i] = (v4u){0u, 0u, 0u, 0u}; }
        if (BOTH(0)) GRID_BAR();
    }

    if (IN(1)) { PHASE_BASES();
        for (int row = gw; row < MT; row += NGW) {
            const float* src; const float* sh; const float* sc;
            if (row < M) { const int b = row / SEQ; src = in_x + (size_t)row * D; sh = MODX + b * MODW; sc = sh + D; }
            else { src = ctx + (size_t)(row - M) * D; sh = MODC; sc = MODC + D; }
            f32x4 v[8], pg[8], ps1[8], ps0[8]; float ss = 0.f;
#pragma unroll
            for (int j = 0; j < 8; ++j) v[j] = __builtin_nontemporal_load((const f32x4*)src + lane + 64 * j);
#pragma unroll
            for (int j = 0; j < 8; ++j) { pg[j] = ((const f32x4*)n_pre_mix)[lane + 64 * j]; ps1[j] = ((const f32x4*)sc)[lane + 64 * j]; ps0[j] = ((const f32x4*)sh)[lane + 64 * j]; }
#pragma unroll
            for (int j = 0; j < 8; ++j) ss += (v[j].x * v[j].x + v[j].y * v[j].y) + (v[j].z * v[j].z + v[j].w * v[j].w);
            const float rstd = 1.0f / sqrtf(wave_sum(ss) * (1.f / D) + EPS);
            v2u* o8 = (v2u*)(HX + (size_t)row * D) + lane;
#pragma unroll
            for (int j = 0; j < 8; ++j) { const f32x4 o = (v[j] * rstd * pg[j]) * (ps1[j] + 1.0f) + ps0[j]; v2u w; w.x = pk2(o.x, o.y); w.y = pk2(o.z, o.w); o8[64 * j] = w; }
        }
        if (BOTH(1)) GRID_BAR();
    }

    if (IN(2)) { PHASE_BASES();
        if (((bx >> 3) & 3) == 0) { const ExpertCopy X{w_e1, w_e3, w_e2, W13, W2}; expert_copy_share(X, ctl + CW_Q1, lane); }
        pg8::Gemm g{HX, WIN, MT, NPROJ, D}; OrderProjDyn S; S.init(ctl + CW_QG, MISC + 24, bx);
        EpiProj E{Zb, XBC, XBCR, SCY, Gt, DTS, ssd_conv_w, ssd_conv_b, sc_conv_w, dt_bias};
        pg8::gemm_phase<EpiProj, OrderProjDyn, true, true>(lds, g, S, E);
        if (BOTH(2)) GRID_BAR();
    }

    if (IN(3)) { PHASE_BASES();
        LAS unsigned char* sBt = lds;
        LAS unsigned char* sXt = lds + 40960;
        LAS float* sW = (LAS float*)(lds + 40960 + 73728) + wave * 128;
        const int r32 = lane & 31, hh = lane >> 5, hl = wave >> 1, dir = wave & 1;
        const int li = lane & 15, tq = li >> 2, tp = li & 3, blk = (lane >> 4) & 1;
        volatile LAS unsigned* qs = MISC + 40;
        __syncthreads();
        if (tid == 0) { const unsigned a0 = __hip_atomic_fetch_add(ctl + CW_Q2, 2u, __ATOMIC_RELAXED, __HIP_MEMORY_SCOPE_AGENT); qs[0] = a0; qs[1] = a0 + 1u; }
        __syncthreads();
#define P3_MAP(q) ((q) < 128 ? (((q) & 1) ? ((q) >> 1) : NCHUNK * 8 - 64 + ((q) >> 1)) : ((q) < NCHUNK * 8 ? (q) - 64 : NCHUNK * 8))
        int item = P3_MAP((int)qs[0]), trip = 0;
        v4u pB[4], pX[8]; float pd0 = 0.f, pd1 = 0.f;
#define P3_REQUEST(itm) do { const int cg_ = (itm) >> 3, grp_ = ((itm) >> 1) & 3, hq_ = (itm) & 1, head_ = grp_ * 8 + hq_ * 4 + hl, row0_ = cg_ * 128; int t1_ = tid; asm volatile("" : "+v"(t1_)); \
            _Pragma("unroll") for (int m = 0; m < 4; ++m) { const int q = t1_ + 512 * m, tok = q >> 4, ck = q & 15; pB[m] = *(const v4u*)(XBC + (size_t)(row0_ + tok) * XBCW + 2048 + grp_ * 128 + ck * 8); } \
            _Pragma("unroll") for (int m = 0; m < 8; ++m) { const int q = t1_ + 512 * m, tok = q >> 5, ck = q & 31; pX[m] = *(const v4u*)(XBC + (size_t)(row0_ + tok) * XBCW + grp_ * 512 + hq_ * 256 + ck * 8); } \
            { const int ln_ = t1_ & 63; pd0 = DTS[(size_t)(row0_ + 2 * ln_) * 64 + dir * 32 + head_]; pd1 = DTS[(size_t)(row0_ + 2 * ln_ + 1) * 64 + dir * 32 + head_]; } } while (0)
        if (item < NCHUNK * 8 && (item >> 3) < 128) P3_REQUEST(item);
        while (item < NCHUNK * 8) {
            const int cg = item >> 3, grp = (item >> 1) & 3, hq = item & 1, head = grp * 8 + hq * 4 + hl, row0 = cg * 128;
            __syncthreads();
            const int nq = (int)qs[(trip + 1) & 3]; const int nitem = P3_MAP(nq);
            unsigned pend = 0u;
            if (tid == 0) { unsigned z; asm volatile("v_mov_b32 %0, 0" : "=v"(z)); pend = __hip_atomic_fetch_add(ctl + CW_Q2 + z, 1u, __ATOMIC_RELAXED, __HIP_MEMORY_SCOPE_AGENT); }
            int t1 = tid; asm volatile("" : "+v"(t1));
            float d0, d1;
            if (cg < 128) {
#pragma unroll
                for (int m = 0; m < 4; ++m) { const int q = t1 + 512 * m, tok = q >> 4, ck = q & 15; *(LAS v4u*)(sBt + tok * 320 + ck * 16) = pB[m]; }
#pragma unroll
                for (int m = 0; m < 8; ++m) { const int q = t1 + 512 * m, tok = q >> 5, ck = q & 31; *(LAS v4u*)(sXt + tok * 576 + ck * 16) = pX[m]; }
                d0 = pd0; d1 = pd1;
            } else {
                { const int ln = t1 & 63; d0 = DTS[(size_t)(row0 + 2 * ln) * 64 + dir * 32 + head]; d1 = DTS[(size_t)(row0 + 2 * ln + 1) * 64 + dir * 32 + head]; }
                { v4u rc_[4], rp_[4], rn_[4];
#pragma unroll
                  for (int m = 0; m < 4; ++m) { const int q = t1 + 512 * m, tok = q >> 4, ck = q & 15, rr_ = row0 - M + tok, pos = rr_ & 255; const bf16* p = XBCR + (size_t)rr_ * XBCW + 2048 + grp * 128 + ck * 8;
                      rc_[m] = *(const v4u*)p; rp_[m] = *(const v4u*)(pos > 0 ? p - XBCW : p); rn_[m] = *(const v4u*)(pos < 255 ? p + XBCW : p); }
#pragma unroll
                  for (int m = 0; m < 4; ++m) { const int q = t1 + 512 * m, tok = q >> 4, ck = q & 15, pos = (row0 - M + tok) & 255; const bool hp = pos > 0, hn = pos < 255;
                      v4u pv_ = rp_[m], nv_ = rn_[m]; pv_.x = hp ? pv_.x : 0u; pv_.y = hp ? pv_.y : 0u; pv_.z = hp ? pv_.z : 0u; pv_.w = hp ? pv_.w : 0u; nv_.x = hn ? nv_.x : 0u; nv_.y = hn ? nv_.y : 0u; nv_.z = hn ? nv_.z : 0u; nv_.w = hn ? nv_.w : 0u;
                      *(LAS v4u*)(sBt + tok * 320 + ck * 16) = conv8r(rc_[m], pv_, nv_, ssd_conv_w, ssd_conv_b, 2048 + grp * 128 + ck * 8); } }
                { v4u rc_[8], rp_[8], rn_[8];
#pragma unroll
                  for (int m = 0; m < 8; ++m) { const int q = t1 + 512 * m, tok = q >> 5, ck = q & 31, rr_ = row0 - M + tok, pos = rr_ & 255; const bf16* p = XBCR + (size_t)rr_ * XBCW + grp * 512 + hq * 256 + ck * 8;
                      rc_[m] = *(const v4u*)p; rp_[m] = *(const v4u*)(pos > 0 ? p - XBCW : p); rn_[m] = *(const v4u*)(pos < 255 ? p + XBCW : p); }
#pragma unroll
                  for (int m = 0; m < 8; ++m) { const int q = t1 + 512 * m, tok = q >> 5, ck = q & 31, pos = (row0 - M + tok) & 255; const bool hp = pos > 0, hn = pos < 255;
                      v4u pv_ = rp_[m], nv_ = rn_[m]; pv_.x = hp ? pv_.x : 0u; pv_.y = hp ? pv_.y : 0u; pv_.z = hp ? pv_.z : 0u; pv_.w = hp ? pv_.w : 0u; nv_.x = hn ? nv_.x : 0u; nv_.y = hn ? nv_.y : 0u; nv_.z = hn ? nv_.z : 0u; nv_.w = hn ? nv_.w : 0u;
                      *(LAS v4u*)(sXt + tok * 576 + ck * 16) = conv8r(rc_[m], pv_, nv_, ssd_conv_w, ssd_conv_b, grp * 512 + hq * 256 + ck * 8); } }
            }
            { int ln = t1 & 63;
              const float a = -expf(a_log[dir * 32 + head]); const float v0 = a * d0, v1 = a * d1;
              float inc = v0 + v1;
#pragma unroll
              for (int o = 1; o < 64; o <<= 1) { const float t = __shfl_up(inc, o); if (ln >= o) inc += t; }
              const float tot = __shfl(inc, 63), ex = inc - (v0 + v1);
              const float w0 = dir ? expf(ex) * d0 : expf(tot - (ex + v0)) * d0, w1 = dir ? expf(ex + v0) * d1 : expf(tot - (ex + v0 + v1)) * d1;
              sW[2 * ln] = w0; sW[2 * ln + 1] = w1;
              if (ln == 0) CHLOG[(cg * 2 + dir) * 32 + head] = tot; }
            __syncthreads();
            if (nitem < NCHUNK * 8 && (nitem >> 3) < 128) P3_REQUEST(nitem);
            __builtin_amdgcn_sched_barrier(0);
            f32x16 acc[4][2];
#pragma unroll
            for (int nt = 0; nt < 4; ++nt)
#pragma unroll
                for (int pt = 0; pt < 2; ++pt)
#pragma unroll
                    for (int k = 0; k < 16; ++k) acc[nt][pt][k] = 0.f;
            const LAS unsigned char* xrd = sXt + (8 * hh + tq) * 576 + (hl * 64 + 16 * blk + 4 * tp) * 2;
            const LAS unsigned char* brd = sBt + (8 * hh + tq) * 320 + (16 * blk + 4 * tp) * 2;
#pragma unroll 2
            for (int s = 0; s < 8; ++s) {
                const f32x4 w0 = *(const LAS f32x4*)(sW + 16 * s + 8 * hh), w1 = *(const LAS f32x4*)(sW + 16 * s + 8 * hh + 4);
                bf16x8 xf[2];
#pragma unroll
                for (int pt = 0; pt < 2; ++pt) { const v2u lo = tr_read(xrd + (16 * s) * 576 + 64 * pt), hi = tr_read(xrd + (16 * s + 4) * 576 + 64 * pt);
                    float t[8] = {bflo(lo.x) * w0[0], bfhi(lo.x) * w0[1], bflo(lo.y) * w0[2], bfhi(lo.y) * w0[3], bflo(hi.x) * w1[0], bfhi(hi.x) * w1[1], bflo(hi.y) * w1[2], bfhi(hi.y) * w1[3]};
                    xf[pt] = __builtin_bit_cast(bf16x8, pack8(t)); }
#pragma unroll
                for (int nt = 0; nt < 4; ++nt) { const v2u lo = tr_read(brd + (16 * s) * 320 + 64 * nt), hi = tr_read(brd + (16 * s + 4) * 320 + 64 * nt);
                    v4u bw; bw.x = lo.x; bw.y = lo.y; bw.z = hi.x; bw.w = hi.y; const bf16x8 bfm = __builtin_bit_cast(bf16x8, bw);
#pragma unroll
                    for (int pt = 0; pt < 2; ++pt) acc[nt][pt] = __builtin_amdgcn_mfma_f32_32x32x16_bf16(bfm, xf[pt], acc[nt][pt], 0, 0, 0); }
            }
            __syncthreads();
            if (tid == 0) qs[(trip + 2) & 3] = pend;
            { LAS unsigned char* sS = lds + wave * 16896;
#pragma unroll
              for (int nt = 0; nt < 4; ++nt)
#pragma unroll
                  for (int pt = 0; pt < 2; ++pt)
#pragma unroll
                      for (int gq = 0; gq < 4; ++gq) { v2u w; w.x = pk2(acc[nt][pt][4 * gq], acc[nt][pt][4 * gq + 1]); w.y = pk2(acc[nt][pt][4 * gq + 2], acc[nt][pt][4 * gq + 3]);
                          *(LAS v2u*)(sS + (32 * pt + r32) * 264 + (32 * nt + 8 * gq + 4 * hh) * 2) = w; }
              LDS_WAIT(); asm volatile("" ::: "memory");
              bf16* stp = ST + ((size_t)(cg * 2 + dir) * 32 + head) * 8192;
#pragma unroll
              for (int k = 0; k < 16; ++k) { const int p = 4 * k + (lane >> 4), c16 = lane & 15;
                  const LAS unsigned char* src = sS + p * 264 + c16 * 16; v4u v; v.x = *(const LAS unsigned*)src; v.y = *(const LAS unsigned*)(src + 4); v.z = *(const LAS unsigned*)(src + 8); v.w = *(const LAS unsigned*)(src + 12);
                  *(v4u*)(stp + p * 128 + c16 * 8) = v; } }
            item = nitem; ++trip;
        }
#undef P3_REQUEST
#undef P3_MAP
        __syncthreads();
        if (BOTH(3)) GRID_BAR();
    }

    if (IN(4)) { PHASE_BASES();
        for (int item = bx; item < NB * NHEAD * 2; item += G) {
            const int b = item >> 6, head = (item >> 1) & 31, dir = item & 1;
            float h[16];
#pragma unroll
            for (int k = 0; k < 16; ++k) h[k] = 0.f;
#pragma unroll 2
            for (int step = 0; step < 34; ++step) {
                const int cg = dir == 0 ? (step < 2 ? 128 + 2 * b + step : 32 * b + (step - 2)) : (step < 2 ? 128 + 2 * b + 1 - step : 32 * b + 31 - (step - 2));
                const size_t base = ((size_t)(cg * 2 + dir) * 32 + head) * 8192;
                const float dec = expf(CHLOG[(cg * 2 + dir) * 32 + head]);
                float s0[8], s1[8]; unpack8(__builtin_nontemporal_load((const v4u*)(ST + base + tid * 8)), s0); unpack8(__builtin_nontemporal_load((const v4u*)(ST + base + 4096 + tid * 8)), s1);
                if (step >= 2) { float t0[8], t1[8];
#pragma unroll
                    for (int k = 0; k < 8; ++k) { t0[k] = h[k]; t1[k] = h[8 + k]; }
                    *(v4u*)(HENT + base + tid * 8) = pack8(t0); *(v4u*)(HENT + base + 4096 + tid * 8) = pack8(t1); }
#pragma unroll
                for (int k = 0; k < 8; ++k) { h[k] = dec * h[k] + s0[k]; h[8 + k] = dec * h[8 + k] + s1[k]; }
            }
        }
        if (BOTH(4)) GRID_BAR();
    }

    if (IN(5)) { PHASE_BASES();
        LAS unsigned char* sBt = lds;
        LAS unsigned char* sCz = lds + 34816;
        LAS unsigned char* sHF = lds + 69632;
        LAS unsigned char* sHB = lds + 87040;
        LAS unsigned char* sX = lds + 104448;
        LAS float* sTab0 = (LAS float*)(lds + 129024);
        LAS float* SSQ = (LAS float*)(lds + 137216);
        LAS unsigned char* sY = lds + 138240;
        const int r32 = lane & 31, hh = lane >> 5, it = wave & 3, pt = wave >> 2, i = 32 * it + r32;
        const int li = lane & 15, tq = li >> 2, tp = li & 3, blk = (lane >> 4) & 1;
        for (int item = claim_item(ctl + CW_Q3, MISC + 17); item < 128 * 4; item = claim_item(ctl + CW_Q3, MISC + 17)) {
            const int cg = item >> 2, grp = item & 3, row0 = cg * 128;
            __syncthreads();
            int t1 = tid; asm volatile("" : "+v"(t1));
#pragma unroll
            for (int m = 0; m < 4; ++m) { const int q = t1 + 512 * m, tok = q >> 4, ck = q & 15;
                *(LAS v4u*)(sBt + tok * 272 + ck * 16) = *(const v4u*)(XBC + (size_t)(row0 + tok) * XBCW + 2048 + grp * 128 + ck * 8);
                *(LAS v4u*)(sCz + tok * 272 + ck * 16) = *(const v4u*)(XBC + (size_t)(row0 + tok) * XBCW + 2560 + grp * 128 + ck * 8); }
            { const int head = grp * 8;
#pragma unroll
              for (int m = 0; m < 4; ++m) { const int q = t1 + 512 * m, which = q >> 10, r = (q & 1023) >> 4, ck = q & 15;
                  *(LAS v4u*)(sHF + which * 17408 + r * 272 + ck * 16) = __builtin_nontemporal_load((const v4u*)(HENT + ((size_t)(cg * 2 + which) * 32 + head) * 8192 + r * 128 + ck * 8)); }
#pragma unroll
              for (int m = 0; m < 2; ++m) { const int q = t1 + 512 * m, tok = q >> 3, ck = q & 7;
                  *(LAS v4u*)(sX + tok * 192 + ck * 16) = *(const v4u*)(XBC + (size_t)(row0 + tok) * XBCW + head * 64 + ck * 8); } }
            float tAF0, tAF1, tAB0, tAB1, tDF0, tDF1, tDB0, tDB1;
            { const int head = grp * 8 + wave; int ln = t1 & 63;
              const float dF0 = DTS[(size_t)(row0 + 2 * ln) * 64 + head], dF1 = DTS[(size_t)(row0 + 2 * ln + 1) * 64 + head];
              const float dB0 = DTS[(size_t)(row0 + 2 * ln) * 64 + 32 + head], dB1 = DTS[(size_t)(row0 + 2 * ln + 1) * 64 + 32 + head];
              const float aF = -expf(a_log[head]), aB = -expf(a_log[32 + head]);
              const float vF0 = aF * dF0, vF1 = aF * dF1, vB0 = aB * dB0, vB1 = aB * dB1;
              float inF = vF0 + vF1, inB = vB0 + vB1;
#pragma unroll
              for (int o = 1; o < 64; o <<= 1) { const float tF = __shfl_up(inF, o), tB = __shfl_up(inB, o); if (ln >= o) { inF += tF; inB += tB; } }
              const float totB = __shfl(inB, 63);
              const float exF = inF - (vF0 + vF1), exB = inB - (vB0 + vB1);
              tAF0 = exF + vF0; tAF1 = exF + vF0 + vF1;
              tAB0 = totB - exB; tAB1 = totB - (exB + vB0);
              tDF0 = dF0; tDF1 = dF1; tDB0 = dB0; tDB1 = dB1; }
#define P6_WRITE_TABLES(hdx) do { int ln = (int)(threadIdx.x & 63u); asm volatile("" : "+v"(ln)); LAS float* sTab = sTab0 + ((hdx) & 1) * 1024; LAS float* sArr = sTab + 512; \
            sArr[2 * ln] = tAF0; sArr[2 * ln + 1] = tAF1; sArr[128 + 2 * ln] = tAB0; sArr[128 + 2 * ln + 1] = tAB1; \
            sArr[256 + 2 * ln] = tDF0; sArr[256 + 2 * ln + 1] = tDF1; sArr[384 + 2 * ln] = tDB0; sArr[384 + 2 * ln + 1] = tDB1; \
            _Pragma("unroll") for (int tt = 0; tt < 4; ++tt) { const float refF = __shfl(tAF0, 16 * tt), refB = __shfl(tAB1, 16 * tt + 15); const int j0 = 2 * ln; \
                sTab[tt * 128 + j0]     = j0 < 32 * tt     ? __expf(refF - tAF0) * tDF0 : (j0 >= 32 * tt + 32     ? __expf(refB - tAB0) * tDB0 : 0.f); \
                sTab[tt * 128 + j0 + 1] = j0 + 1 < 32 * tt ? __expf(refF - tAF1) * tDF1 : (j0 + 1 >= 32 * tt + 32 ? __expf(refB - tAB1) * tDB1 : 0.f); } } while (0)
            if (wave == 0) P6_WRITE_TABLES(0);
            __syncthreads();
            bf16x8 cf[8];
#pragma unroll
            for (int s = 0; s < 8; ++s) cf[s] = *(const LAS bf16x8*)(sCz + i * 272 + 32 * s + 16 * hh);
            __syncthreads();
            { const int head = grp * 8;
#pragma unroll
              for (int m = 0; m < 2; ++m) { const int q = t1 + 512 * m, tok = q >> 3, ck = q & 7;
                  *(LAS v4u*)(sCz + tok * 192 + ck * 16) = *(const v4u*)(Zb + (size_t)(row0 + tok) * D + head * 64 + ck * 8); } }
            __syncthreads();
            float ssq_acc = 0.f;
#pragma unroll 1
            for (int hd = 0; hd < 8; ++hd) {
                const int head = grp * 8 + hd;
                int t2 = tid; asm volatile("" : "+v"(t2));
                int iv = r32; asm volatile("" : "+v"(iv));
                if (wave == hd + 1) P6_WRITE_TABLES(hd + 1);
                const LAS float* sTab = sTab0 + (hd & 1) * 1024; const LAS float* sArr = sTab + 512;
                v4u pfh[4], pfz[2], pxc[2];
                if (hd < 7) {
#pragma unroll
                    for (int m = 0; m < 4; ++m) { const int q = t2 + 512 * m, which = q >> 10, r = (q & 1023) >> 4, ck = q & 15;
                        pfh[m] = __builtin_nontemporal_load((const v4u*)(HENT + ((size_t)(cg * 2 + which) * 32 + head + 1) * 8192 + r * 128 + ck * 8)); }
#pragma unroll
                    for (int m = 0; m < 2; ++m) { const int q = t2 + 512 * m, tok = q >> 3, ck = q & 7; const size_t r = (size_t)(row0 + tok);
                        pfz[m] = __builtin_nontemporal_load((const v4u*)(Zb + r * D + (head + 1) * 64 + ck * 8)); pxc[m] = __builtin_nontemporal_load((const v4u*)(XBC + r * XBCW + (head + 1) * 64 + ck * 8)); } }
                __builtin_amdgcn_sched_barrier(0);
                const LAS unsigned char* pHF = sHF + (32 * pt + r32) * 272 + 16 * hh; asm volatile("" : "+v"(pHF));
                const LAS unsigned char* pHB = sHB + (32 * pt + r32) * 272 + 16 * hh; asm volatile("" : "+v"(pHB));
                const LAS unsigned char* pBt = sBt + r32 * 272 + 16 * hh; asm volatile("" : "+v"(pBt));
                const LAS float* pTab = sTab + it * 128 + 4 * hh; asm volatile("" : "+v"(pTab));
                const LAS float* pArr = sArr + 4 * hh; asm volatile("" : "+v"(pArr));
                const LAS float* pArrI = sArr + i; asm volatile("" : "+v"(pArrI));
                const LAS float* pArrT = sArr + 32 * it; asm volatile("" : "+v"(pArrT));
                const LAS unsigned char* pXi = sX + i * 192 + 64 * pt + 8 * hh; asm volatile("" : "+v"(pXi));
                const LAS unsigned char* pZi = sCz + i * 192 + 64 * pt + 8 * hh; asm volatile("" : "+v"(pZi));
                const float aFi = pArrI[0], aBi = pArrI[128];
                const float eF = expf(aFi), eB = expf(aBi), rowF = __expf(aFi - pArrT[0]), rowB = __expf(aBi - pArrT[128 + 31]);
                f32x16 acc, tL;
#pragma unroll
                for (int k = 0; k < 16; ++k) { acc[k] = 0.f; tL[k] = 0.f; }
#pragma unroll
                for (int s = 0; s < 8; ++s) {
                    acc = __builtin_amdgcn_mfma_f32_32x32x16_bf16(*(const LAS bf16x8*)(pHF + 32 * s), cf[s], acc, 0, 0, 0);
                    tL = __builtin_amdgcn_mfma_f32_32x32x16_bf16(*(const LAS bf16x8*)(pHB + 32 * s), cf[s], tL, 0, 0, 0); }
#pragma unroll
                for (int k = 0; k < 16; ++k) { acc[k] = acc[k] * eF + tL[k] * eB; tL[k] = 0.f; }
                const LAS unsigned char* xrd = sX + (4 * hh + tq) * 192 + (32 * pt + 16 * blk + 4 * tp) * 2; asm volatile("" : "+v"(xrd));
#pragma unroll
                for (int jt = 0; jt < 4; ++jt) {
                    __builtin_amdgcn_sched_barrier(0);
                    f32x16 Xf;
#pragma unroll
                    for (int k = 0; k < 16; ++k) Xf[k] = 0.f;
#pragma unroll
                    for (int s = 0; s < 8; ++s) Xf = __builtin_amdgcn_mfma_f32_32x32x16_bf16(*(const LAS bf16x8*)(pBt + (32 * jt) * 272 + 32 * s), cf[s], Xf, 0, 0, 0);
                    if (jt != it) {
#pragma unroll
                        for (int gq = 0; gq < 4; ++gq) { const f32x4 T = *(const LAS f32x4*)(pTab + 32 * jt + 8 * gq);
#pragma unroll
                            for (int q = 0; q < 4; ++q) Xf[4 * gq + q] *= T[q]; }
                    } else {
#pragma unroll
                        for (int gq = 0; gq < 4; ++gq) { const int jl0 = 8 * gq + 4 * hh;
                            const f32x4 AF = *(const LAS f32x4*)(pArr + 32 * jt + 8 * gq), AB = *(const LAS f32x4*)(pArr + 128 + 32 * jt + 8 * gq), DF = *(const LAS f32x4*)(pArr + 256 + 32 * jt + 8 * gq), DB = *(const LAS f32x4*)(pArr + 384 + 32 * jt + 8 * gq);
#pragma unroll
                            for (int q = 0; q < 4; ++q) { const int jl = jl0 + q; const bool lower = jl < iv;
                                const float arg = lower ? aFi - AF[q] : aBi - AB[q]; float f = __expf(arg) * (lower ? DF[q] : DB[q]); f += (jl == iv) ? DF[q] : 0.f;
                                Xf[4 * gq + q] *= f; } }
                    }
                    bf16x8 mf[2], xa[2];
#pragma unroll
                    for (int ss = 0; ss < 2; ++ss) { v4u w; w.x = pk2(Xf[8 * ss + 0], Xf[8 * ss + 1]); w.y = pk2(Xf[8 * ss + 2], Xf[8 * ss + 3]); w.z = pk2(Xf[8 * ss + 4], Xf[8 * ss + 5]); w.w = pk2(Xf[8 * ss + 6], Xf[8 * ss + 7]);
                        mf[ss] = __builtin_bit_cast(bf16x8, w);
                        const v2u lo = tr_read(xrd + (32 * jt + 16 * ss) * 192), hi = tr_read(xrd + (32 * jt + 16 * ss + 8) * 192); v4u xw; xw.x = lo.x; xw.y = lo.y; xw.z = hi.x; xw.w = hi.y;
                        xa[ss] = __builtin_bit_cast(bf16x8, xw); }
                    if (jt != it) { tL = __builtin_amdgcn_mfma_f32_32x32x16_bf16(xa[0], mf[0], tL, 0, 0, 0); tL = __builtin_amdgcn_mfma_f32_32x32x16_bf16(xa[1], mf[1], tL, 0, 0, 0); }
                    else {
#pragma unroll
                        for (int k = 0; k < 16; ++k) { acc[k] += rowF * tL[k]; tL[k] = 0.f; }
                        acc = __builtin_amdgcn_mfma_f32_32x32x16_bf16(xa[0], mf[0], acc, 0, 0, 0); acc = __builtin_amdgcn_mfma_f32_32x32x16_bf16(xa[1], mf[1], acc, 0, 0, 0); }
                }
#pragma unroll
                for (int k = 0; k < 16; ++k) acc[k] += rowB * tL[k];
                {
                    const float Dh = ssd_d[head];
                    LAS unsigned char* pY = sY + i * 128; asm volatile("" : "+v"(pY));
#pragma unroll
                    for (int gq = 0; gq < 4; ++gq) {
                        const v2u xw = *(const LAS v2u*)(pXi + 16 * gq), zw = *(const LAS v2u*)(pZi + 16 * gq);
                        const float xv[4] = {bflo(xw.x), bfhi(xw.x), bflo(xw.y), bfhi(xw.y)}, zv[4] = {bflo(zw.x), bfhi(zw.x), bflo(zw.y), bfhi(zw.y)};
                        float y[4];
#pragma unroll
                        for (int q = 0; q < 4; ++q) { y[q] = (acc[4 * gq + q] + Dh * xv[q]) * siluf(zv[q]); ssq_acc += y[q] * y[q]; }
                        v2u w; w.x = pk2(y[0], y[1]); w.y = pk2(y[2], y[3]);
                        *(LAS v2u*)(pY + (((8 * pt + 2 * gq + hh) ^ (iv & 15)) << 3)) = w; }
                }
                __syncthreads();
                { const int tok = t2 >> 2, c16 = t2 & 3; const LAS unsigned char* src = sY + tok * 128; v2u c[4];
#pragma unroll
                  for (int k = 0; k < 4; ++k) c[k] = *(const LAS v2u*)(src + (((4 * c16 + k) ^ (tok & 15)) << 3));
                  bf16* dst = Yn + (size_t)(row0 + tok) * D + head * 64 + 16 * c16;
                  v4u w0; w0.x = c[0].x; w0.y = c[0].y; w0.z = c[1].x; w0.w = c[1].y; v4u w1; w1.x = c[2].x; w1.y = c[2].y; w1.z = c[3].x; w1.w = c[3].y;
                  *(v4u*)dst = w0; *(v4u*)(dst + 8) = w1; }
                if (hd < 7) {
#pragma unroll
                    for (int m = 0; m < 4; ++m) { const int q = t2 + 512 * m, which = q >> 10, r = (q & 1023) >> 4, ck = q & 15;
                        *(LAS v4u*)(sHF + which * 17408 + r * 272 + ck * 16) = pfh[m]; }
#pragma unroll
                    for (int m = 0; m < 2; ++m) { const int q = t2 + 512 * m, tok = q >> 3, ck = q & 7;
                        *(LAS v4u*)(sCz + tok * 192 + ck * 16) = pfz[m];
                        *(LAS v4u*)(sX + tok * 192 + ck * 16) = pxc[m]; }
                }
                __syncthreads();
            }
#undef P6_WRITE_TABLES
            ssq_acc += __shfl_xor(ssq_acc, 32);
            if (lane < 32) SSQ[pt * 128 + i] = ssq_acc;
            VM_WAIT();
            __syncthreads();
            {
                v4u wv[16];
                bf16* yb = Yn + (size_t)(row0 + wave * 16) * D + grp * 512 + lane * 8;
#pragma unroll
                for (int r = 0; r < 16; ++r) wv[r] = *(const v4u*)(yb + (size_t)r * D);
#pragma unroll
                for (int r = 0; r < 16; ++r) { const float tot = SSQ[wave * 16 + r] + SSQ[128 + wave * 16 + r];
                    const float rstd = 1.0f / sqrtf(tot * (1.f / 512.f) + EPS);
                    float t[8]; unpack8(wv[r], t);
#pragma unroll
                    for (int e = 0; e < 8; ++e) t[e] *= rstd;
                    *(v4u*)(yb + (size_t)r * D) = pack8(t); }
            }
        }
        __syncthreads();
        if (BOTH(5)) GRID_BAR();
    }

    if (IN(6)) { PHASE_BASES();
        { pg8::Gemm g{Yn, WSSD, M, D, D, SCY, WSC}; OrderTwice S; S.so.init(M, D, G, bx); S.R = (512 + G - 1) / G; EpiGate E{Gt, b_gate, MERGED};
          pg8::gemm_phase<EpiGate, OrderTwice, true, true>(lds, g, S, E); }
        if (BOTH(6)) GRID_BAR();
    }

    if (IN(7)) { PHASE_BASES();
        pg8::Gemm g{MERGED, WO, M, D, D}; pg8::StaticOrder S; S.init(M, D, G, bx); EpiBf16Plain E{OUTX, D};
        pg8::gemm_phase<EpiBf16Plain, pg8::StaticOrder, true, true>(lds, g, S, E);
        if (BOTH(7)) GRID_BAR();
    }

    if (IN(8)) { PHASE_BASES();
        LAS float* wrT = (LAS float*)lds;
        for (int ch = tid; ch < D; ch += NWAVES * 64) { f32x4 wv[4];
#pragma unroll
            for (int q = 0; q < 4; ++q) wv[q] = ((const f32x4*)(w_router + (size_t)ch * NE))[q];
#pragma unroll
            for (int q = 0; q < 4; ++q) { wrT[(4 * q + 0) * D + ch] = wv[q].x; wrT[(4 * q + 1) * D + ch] = wv[q].y; wrT[(4 * q + 2) * D + ch] = wv[q].z; wrT[(4 * q + 3) * D + ch] = wv[q].w; } }
        __syncthreads();
        LAS f32x4* pv = (LAS f32x4*)(lds + 131072);
        for (int trip = 0; trip * 2 * NGW < M; ++trip) {
            const int row0 = 2 * gw + trip * 2 * NGW; const int b = (16 * bx + trip * 2 * NGW) / SEQ;
            __syncthreads();
            { const float* md = MODX + b * MODW;
              for (int c4 = tid; c4 < D / 4; c4 += NWAVES * 64) { const f32x4 gpm = ((const f32x4*)n_post_mix)[c4], gx = ((const f32x4*)(md + 2 * D))[c4], gpf = ((const f32x4*)n_pre_ffn)[c4], s0 = ((const f32x4*)(md + 3 * D))[c4], s1 = ((const f32x4*)(md + 4 * D))[c4];
                  pv[c4] = gx * gpm; pv[D / 4 + c4] = gpf * (s1 + 1.0f); pv[2 * (D / 4) + c4] = s0; } }
            __syncthreads();
            if (row0 >= M) continue;
            f32x4 va[8], vb[8];
            v2u owa[8], owb[8]; f32x4 xra[8], xrb[8];
#pragma unroll
            for (int j = 0; j < 8; ++j) { owa[j] = __builtin_nontemporal_load((const v2u*)(OUTX + (size_t)row0 * D) + lane + 64 * j); owb[j] = __builtin_nontemporal_load((const v2u*)(OUTX + (size_t)(row0 + 1) * D) + lane + 64 * j); }
#pragma unroll
            for (int j = 0; j < 8; ++j) { xra[j] = __builtin_nontemporal_load((const f32x4*)(in_x + (size_t)row0 * D) + lane + 64 * j); xrb[j] = __builtin_nontemporal_load((const f32x4*)(in_x + (size_t)(row0 + 1) * D) + lane + 64 * j); }
#pragma unroll
            for (int rr = 0; rr < 2; ++rr) {
                const int row = row0 + rr; f32x4 v[8]; float ss = 0.f;
#pragma unroll
                for (int j = 0; j < 8; ++j) { const v2u ow = rr ? owb[j] : owa[j]; v[j] = (f32x4){bflo(ow.x), bfhi(ow.x), bflo(ow.y), bfhi(ow.y)}; ss += (v[j].x * v[j].x + v[j].y * v[j].y) + (v[j].z * v[j].z + v[j].w * v[j].w); }
                const float rstd1 = 1.0f / sqrtf(wave_sum(ss) * (1.f / D) + EPS);
                float ss2 = 0.f;
#pragma unroll
                for (int j = 0; j < 8; ++j) { const f32x4 xr = rr ? xrb[j] : xra[j], a1 = pv[lane + 64 * j];
                    v[j] = xr + a1 * (v[j] * rstd1); ((f32x4*)(out + (size_t)row * D))[lane + 64 * j] = v[j];
                    ss2 += (v[j].x * v[j].x + v[j].y * v[j].y) + (v[j].z * v[j].z + v[j].w * v[j].w); }
                const float rstd2 = 1.0f / sqrtf(wave_sum(ss2) * (1.f / D) + EPS);
                v2u* o8 = (v2u*)(HX2 + (size_t)row * D) + lane;
#pragma unroll
                for (int j = 0; j < 8; ++j) { const f32x4 a2 = pv[D / 4 + lane + 64 * j], a3 = pv[2 * (D / 4) + lane + 64 * j];
                    v[j] = (v[j] * rstd2) * a2 + a3; v2u w; w.x = pk2(v[j].x, v[j].y); w.y = pk2(v[j].z, v[j].w); o8[64 * j] = w;
                    if (rr == 0) va[j] = v[j]; else vb[j] = v[j]; }
            }
            float q8a[8], q8b[8];
            const bool h5 = (lane & 32) != 0, h4 = (lane & 16) != 0, h3 = (lane & 8) != 0, h2 = (lane & 4) != 0;
#pragma unroll
            for (int e = 0; e < 8; ++e) {
                pg8::f32x2 pa0 = {0.f, 0.f}, pb0 = pa0, pa1 = pa0, pb1 = pa0;
                { __builtin_amdgcn_sched_barrier(0);
                  f32x4 w0[8];
#pragma unroll
                  for (int j = 0; j < 8; ++j) w0[j] = ((const LAS f32x4*)(wrT + e * D))[lane + 64 * j];
#pragma unroll
                  for (int j = 0; j < 8; ++j) {
                    pa0 = __builtin_elementwise_fma(va[j].xy, w0[j].xy, pa0); pa0 = __builtin_elementwise_fma(va[j].zw, w0[j].zw, pa0);
                    pb0 = __builtin_elementwise_fma(vb[j].xy, w0[j].xy, pb0); pb0 = __builtin_elementwise_fma(vb[j].zw, w0[j].zw, pb0); } }
                { __builtin_amdgcn_sched_barrier(0);
                  f32x4 w1[8];
#pragma unroll
                  for (int j = 0; j < 8; ++j) w1[j] = ((const LAS f32x4*)(wrT + (e + 8) * D))[lane + 64 * j];
#pragma unroll
                  for (int j = 0; j < 8; ++j) {
                    pa1 = __builtin_elementwise_fma(va[j].xy, w1[j].xy, pa1); pa1 = __builtin_elementwise_fma(va[j].zw, w1[j].zw, pa1);
                    pb1 = __builtin_elementwise_fma(vb[j].xy, w1[j].xy, pb1); pb1 = __builtin_elementwise_fma(vb[j].zw, w1[j].zw, pb1); } }
                const float sa0 = pa0.x + pa0.y, sb0 = pb0.x + pb0.y, sa1 = pa1.x + pa1.y, sb1 = pb1.x + pb1.y;
                { const float r = __shfl_xor(h5 ? sa0 : sa1, 32); q8a[e] = (h5 ? sa1 : sa0) + r; }
                { const float r = __shfl_xor(h5 ? sb0 : sb1, 32); q8b[e] = (h5 ? sb1 : sb0) + r; }
                __builtin_amdgcn_sched_barrier(0); }
#pragma unroll
            for (int rr = 0; rr < 2; ++rr) {
                float q8[8], q4[4], q2[2], q1;
#pragma unroll
                for (int k = 0; k < 8; ++k) q8[k] = rr ? q8b[k] : q8a[k];
#pragma unroll
                for (int k = 0; k < 4; ++k) { const float r = __shfl_xor(h4 ? q8[k] : q8[k + 4], 16); q4[k] = (h4 ? q8[k + 4] : q8[k]) + r; }
#pragma unroll
                for (int k = 0; k < 2; ++k) { const float r = __shfl_xor(h3 ? q4[k] : q4[k + 2], 8); q2[k] = (h3 ? q4[k + 2] : q4[k]) + r; }
                { const float r = __shfl_xor(h2 ? q2[0] : q2[1], 4); q1 = (h2 ? q2[1] : q2[0]) + r; }
                q1 += __shfl_xor(q1, 2); q1 += __shfl_xor(q1, 1);
                float mx = q1;
#pragma unroll
                for (int o = 4; o < 64; o <<= 1) mx = fmaxf(mx, __shfl_xor(mx, o));
                const float ex = expf(q1 - mx); float den = ex;
#pragma unroll
                for (int o = 4; o < 64; o <<= 1) den += __shfl_xor(den, o);
                const int t = (row0 + rr) % SEQ;
                if ((lane & 3) == 0) AFF[(size_t)(b * NE + (lane >> 2)) * SEQ + t] = ex / den;
            }
        }
        __syncthreads();
        if (BOTH(8)) GRID_BAR();
    }

    if (IN(9)) { PHASE_BASES();
        {
            LAS unsigned* hist = (LAS unsigned*)lds;
            LAS unsigned* shv = hist + 256;
            for (int be = bx; be < NB * NE; be += G) {
                const f32x4 va = ((const f32x4*)(AFF + (size_t)be * SEQ))[2 * tid], vb = ((const f32x4*)(AFF + (size_t)be * SEQ))[2 * tid + 1];
                float vals[8] = {va.x, va.y, va.z, va.w, vb.x, vb.y, vb.z, vb.w};
                unsigned key[8];
#pragma unroll
                for (int k = 0; k < 8; ++k) { const unsigned u = __builtin_bit_cast(unsigned, vals[k]); key[k] = (u & 0x80000000u) ? ~u : (u | 0x80000000u); }
                unsigned prefix = 0u, mask = 0u, need = (unsigned)CAP;
#pragma unroll 1
                for (int pass = 0; pass < 4; ++pass) {
                    const int shift = 24 - 8 * pass;
                    __syncthreads();
                    if (tid < 256) hist[tid] = 0u;
                    __syncthreads();
#pragma unroll
                    for (int k = 0; k < 8; ++k) if ((key[k] & mask) == prefix) __hip_atomic_fetch_add(&hist[(key[k] >> shift) & 255u], 1u, __ATOMIC_RELAXED, __HIP_MEMORY_SCOPE_WORKGROUP);
                    __syncthreads();
                    unsigned mine = 0u, incl = 0u;
                    if (wave < 4) { mine = hist[tid]; incl = mine;
#pragma unroll
                        for (int o = 1; o < 64; o <<= 1) { const unsigned t = __shfl_down(incl, o); if (lane + o < 64) incl += t; }
                        if (lane == 0) shv[24 + wave] = incl; }
                    __syncthreads();
                    if (wave < 4) { unsigned above = incl - mine;
                        for (int w = wave + 1; w < 4; ++w) above += shv[24 + w];
                        if (above < need && above + mine >= need) { shv[0] = prefix | ((unsigned)tid << shift); shv[1] = need - above; } }
                    __syncthreads();
                    prefix = shv[0]; need = shv[1]; mask |= 0xffu << shift;
                }
                const unsigned thr = prefix;
                unsigned cg_ = 0u, ce_ = 0u;
#pragma unroll
                for (int k = 0; k < 8; ++k) { cg_ += key[k] > thr ? 1u : 0u; ce_ += key[k] == thr ? 1u : 0u; }
                unsigned ig = cg_, ie = ce_;
#pragma unroll
                for (int o = 1; o < 64; o <<= 1) { const unsigned tg = __shfl_up(ig, o), te = __shfl_up(ie, o); if (lane >= o) { ig += tg; ie += te; } }
                if (lane == 63) { shv[8 + wave] = ig; shv[16 + wave] = ie; }
                __syncthreads();
                unsigned og = ig - cg_, oe = ie - ce_;
                for (int w = 0; w < wave; ++w) { og += shv[8 + w]; oe += shv[16 + w]; }
#pragma unroll
                for (int k = 0; k < 8; ++k) { const int t = 8 * tid + k; const bool gt = key[k] > thr, eq = key[k] == thr; const bool sel = gt || (eq && oe < need);
                    const unsigned slot = og + (oe < need ? oe : need);
                    if (sel) { IDX[be * CAP + slot] = (be / NE) * SEQ + t; VAL[be * CAP + slot] = vals[k]; }
                    SLOT[(size_t)be * SEQ + t] = sel ? (int)slot : -1;
                    og += gt ? 1u : 0u; oe += eq ? 1u : 0u; }
            }
            __syncthreads();
        }
        { const ExpertCopy X{w_e1, w_e3, w_e2, W13, W2}; expert_copy_share(X, ctl + CW_Q1, lane); }
        if (BOTH(9)) GRID_BAR();
    }

    if (IN(10)) { PHASE_BASES();
        pg8::Gemm g{HX2, W13, NB * NE * CAP, NE * 2 * FF, D}; OrderMoe<16> S; S.init(G, bx); EpiMoe1 E{ACT};
        pg8::gemm_phase_gather<EpiMoe1, OrderMoe<16>>(lds, g, IDX, (LAS int*)(lds + 131072), S, E);
        if (BOTH(10)) GRID_BAR();
    }

    if (IN(11)) { PHASE_BASES();
        pg8::Gemm g{ACT, W2, NB * NE * CAP, NE * D, FF}; OrderMoe<8> S; S.init(G, bx); EpiMoe2 E{OUTE, VAL};
        pg8::gemm_phase<EpiMoe2, OrderMoe<8>, true, true>(lds, g, S, E);
        if (BOTH(11)) GRID_BAR();
    }

    if (IN(12)) { PHASE_BASES();
        for (int row = gw; row < M; row += NGW) {
            const int b = row / SEQ, t = row % SEQ; const float* md = MODX + b * MODW;
            const int myslot = lane < NE ? SLOT[(size_t)(b * NE + lane) * SEQ + t] : -1;
            f32x4 xo[8], pg[8], pf[8];
#pragma unroll
            for (int j = 0; j < 8; ++j) xo[j] = __builtin_nontemporal_load((const f32x4*)(out + (size_t)row * D) + lane + 64 * j);
#pragma unroll
            for (int j = 0; j < 8; ++j) { pg[j] = ((const f32x4*)n_post_ffn)[lane + 64 * j]; pf[j] = ((const f32x4*)(md + 5 * D))[lane + 64 * j]; }
            f32x4 acc[8];
#pragma unroll
            for (int j = 0; j < 8; ++j) acc[j] = (f32x4){0.f, 0.f, 0.f, 0.f};
            unsigned long long sel = __ballot(myslot >= 0);
            while (sel) { const int e = __builtin_ctzll(sel); sel &= sel - 1; const int s = __shfl(myslot, e);
                const v2u* src = (const v2u*)(OUTE + (size_t)((b * NE + e) * CAP + s) * D);
#pragma unroll
                for (int j = 0; j < 8; ++j) { const v2u w = __builtin_nontemporal_load(src + lane + 64 * j); acc[j] += (f32x4){bflo(w.x), bfhi(w.x), bflo(w.y), bfhi(w.y)}; } }
            float ss = 0.f;
#pragma unroll
            for (int j = 0; j < 8; ++j) ss += (acc[j].x * acc[j].x + acc[j].y * acc[j].y) + (acc[j].z * acc[j].z + acc[j].w * acc[j].w);
            const float rstd = 1.0f / sqrtf(wave_sum(ss) * (1.f / D) + EPS);
#pragma unroll
            for (int j = 0; j < 8; ++j) __builtin_nontemporal_store(xo[j] + pf[j] * (acc[j] * rstd * pg[j]), (f32x4*)(out + (size_t)row * D) + lane + 64 * j);
        }
    }
#undef in_x
#undef cvec
#undef ctx
#undef c_ctx
#undef w_mod
#undef b_mod
#undef n_pre_mix
#undef n_post_mix
#undef w_in
#undef ssd_conv_w
#undef ssd_conv_b
#undef dt_bias
#undef a_log
#undef ssd_d
#undef ssd_norm_w
#undef w_ssd_out
#undef sc_conv_w
#undef w_sc_out
#undef b_gate
#undef w_o
#undef n_pre_ffn
#undef n_post_ffn
#undef w_router
#undef w_e1
#undef w_e3
#undef w_e2
#undef out
#undef MODX
#undef MODC
#undef AFF
#undef SLOT
#undef IDX
#undef VAL
#undef DTS
#undef WIN
#undef WSSD
#undef WSC
#undef WO
#undef HX
#undef Zb
#undef XBC
#undef XBCR
#undef Gt
#undef SCY
#undef ST
#undef HENT
#undef CHLOG
#undef Yn
#undef MERGED
#undef OUTX
#undef HX2
#undef W13
#undef W2
#undef ACT
#undef OUTE
#undef KARG
#undef PHASE_BASES
#undef KAS
#undef IN
#undef BOTH
#undef GRID_BAR
}

extern "C" void kernel_launch(void* const* d_in, const int* in_sizes, int n_in, void* d_out, int out_size, void* d_ws, size_t ws_size, hipStream_t stream) {
    static int grid = 0;
    if (grid == 0) {
        if (n_in != 26 || in_sizes[0] != M * D || out_size != M * D || ws_size < WS_END) { fprintf(stderr, "kernel_launch: unexpected shapes (n_in %d, in0 %d, out %d, ws %zu < %zu); nothing launched\n", n_in, n_in > 0 ? in_sizes[0] : -1, out_size, ws_size, (size_t)WS_END); grid = -1; return; }
        int dev = 0, cus = 0, per_cu = 0;
        if (hipGetDevice(&dev) != hipSuccess || hipDeviceGetAttribute(&cus, hipDeviceAttributeMultiprocessorCount, dev) != hipSuccess) { grid = -1; return; }
        if (hipFuncSetAttribute((const void*)mk_fwd, hipFuncAttributeMaxDynamicSharedMemorySize, LDS_BYTES) != hipSuccess) { fprintf(stderr, "kernel_launch: hipFuncSetAttribute failed\n"); grid = -1; return; }
        if (hipOccupancyMaxActiveBlocksPerMultiprocessor(&per_cu, (const void*)mk_fwd, NWAVES * 64, LDS_BYTES) != hipSuccess || per_cu < 1)
            fprintf(stderr, "kernel_launch: note: occupancy query reports %d workgroups per CU\n", per_cu);
        (void)hipGetLastError();
        grid = cus;
    }
    if (grid < 0) return;
    if (hipMemsetAsync((char*)d_ws + WS_CTL, 0, CTL_ZERO_BYTES, stream) != hipSuccess) { fprintf(stderr, "kernel_launch: memset failed\n"); return; }
    Args a{};
    for (int i = 0; i < 26; ++i) a.in[i] = (const float*)d_in[i];
    a.out = (float*)d_out; a.ws = (unsigned char*)d_ws;
#if MK_N_LAUNCHES == 1
    a.ph_lo = 0; a.ph_hi = NPHASES;
    hipLaunchKernelGGL(mk_fwd, dim3(grid), dim3(NWAVES * 64), LDS_BYTES, stream, a);
#else
    for (int p = 0; p < NPHASES; ++p) { a.ph_lo = p; a.ph_hi = p + 1; hipLaunchKernelGGL(mk_fwd, dim3(grid), dim3(NWAVES * 64), LDS_BYTES, stream, a); }
#endif
    const hipError_t le = hipPeekAtLastError();
    if (le != hipSuccess) fprintf(stderr, "kernel_launch: launch failed: %s\n", hipGetErrorName(le));
}
```

```cpp
#include <hip/hip_runtime.h>
#include <cstdio>
#include <cstdint>
namespace pg8 {
#define PG8_LAS __attribute__((address_space(3)))
typedef unsigned short bf16_t;
typedef short bf16x8 __attribute__((ext_vector_type(8)));
typedef float f32x4 __attribute__((ext_vector_type(4)));
typedef unsigned u32x4 __attribute__((ext_vector_type(4)));
constexpr int BM = 256, BK = 64, HALF = 128, HTB = HALF * BK * 2  , STAGE_BYTES = 8 * HTB, NXCD = 8, WGM = 8;

__host__ __device__ __forceinline__ int lds_byte(int r, int c) { const int st = (r >> 4) * 2 + (c >> 5), rr = r & 15, cc = c & 31, ob = rr * 64 + cc * 2; return st * 1024 + (ob ^ (((ob >> 9) & 1) << 5)); }
__host__ __device__ __forceinline__ void stage_rc(int b, int& R, int& C) { const int st = b / 1024, sb = b % 1024, swz = sb ^ (((sb >> 9) & 1) << 5); R = (st >> 1) * 16 + swz / 64; C = (st & 1) * 32 + (swz % 64) / 2; }
__host__ __device__ __forceinline__ int perm32(int rho) { const int n = rho >> 4, i = rho & 15; return 8 * (i >> 2) + 4 * n + (i & 3); }

struct Unit { int pm, pn; int sel = 0; };
struct Gemm { const bf16_t* A; const bf16_t* Bt; int M, N, K; const bf16_t* A2 = nullptr; const bf16_t* Bt2 = nullptr; };

struct StaticOrder {
    static constexpr bool DYNAMIC = false;
    int nM, nN, nwg, G, c;
    __host__ __device__ __forceinline__ void init(int M, int N, int G_, int c_) { nM = M / BM; nN = N / BM; nwg = nM * nN; G = G_; c = c_; }
    __host__ __device__ __forceinline__ bool next(int i, Unit& u) const {
        const long L = (long)i * G + c; if (L >= nwg) return false;
        int wgid = (int)L; { const int q = nwg / NXCD, r = nwg % NXCD, xcd = wgid % NXCD, off = wgid / NXCD; wgid = (xcd < r ? xcd * (q + 1) : r * (q + 1) + (xcd - r) * q) + off; }
        const int nig = WGM * nN, gid = wgid / nig, fm = gid * WGM, gsz = (nM - fm) < WGM ? (nM - fm) : WGM;
        u.pm = fm + ((wgid % nig) % gsz); u.pn = (wgid % nig) / gsz; return true;
    }
    __device__ __forceinline__ void a_ready(const Unit&) const {}
    __device__ __forceinline__ void done(const Unit&) const {}
};

__device__ __forceinline__ unsigned cvt_pk_bf16(float lo, float hi) { unsigned r; asm volatile("v_cvt_pk_bf16_f32 %0, %1, %2" : "=v"(r) : "v"(lo), "v"(hi)); return r; }
typedef float f32x2 __attribute__((ext_vector_type(2)));
template <class Epi, class Sched, bool ALIGN_EPI = false, bool SP2 = false>
__device__ __forceinline__ void gemm_phase(PG8_LAS unsigned char* lds, const Gemm g, const Sched& S, const Epi& E) {
    const int tid = threadIdx.x, wid = __builtin_amdgcn_readfirstlane(tid >> 6), lane = tid & 63, wr = wid >> 2, wc = wid & 3, fr = lane & 15, fq = lane >> 4;
    const int K = g.K, nt = K / BK;
    unsigned voffA[2], voffB[2];
#pragma unroll
    for (int i = 0; i < 2; ++i) { int R, C; stage_rc(tid * 16 + i * 8192, R, C); const int Rb = Epi::PERM ? ((R & ~31) + perm32(R & 31)) : R;
        voffA[i] = (unsigned)(R * K + C) * 2u; voffB[i] = (unsigned)(Rb * K + C) * 2u; }
    const size_t kstep = (size_t)(BK * 2);
    const size_t hstep = (size_t)HALF * K * 2;
    const size_t tstep = 2 * hstep;
    const unsigned ldsw = (unsigned)wid * 1024u;
    const int aoff = lds_byte(wr * 64 + fr, fq * 8), boff = lds_byte(wc * 32 + fr, fq * 8);
#define PG8_SA(b, h) (((b) * 2 + (h)) * HTB)
#define PG8_SB(b, h) ((4 + (b) * 2 + (h)) * HTB)
#define PG8_STAGE(bufoff, gbase, voff) do { _Pragma("unroll") for (int _i = 0; _i < 2; ++_i) \
        __builtin_amdgcn_global_load_lds((const unsigned*)((const char*)(gbase) + (voff)[_i]), (PG8_LAS unsigned*)(lds + (bufoff) + ldsw + _i * 8192), 16, 0, 0); } while (0)
#define PG8_LDA(dst, b, h) do { _Pragma("unroll") for (int m = 0; m < 4; ++m) _Pragma("unroll") for (int k = 0; k < 2; ++k) dst[m][k] = *(const PG8_LAS bf16x8*)(lds + PG8_SA(b, h) + aoff + m * 2048 + k * 1024); } while (0)
#define PG8_LDB(dst, b, h) do { _Pragma("unroll") for (int n = 0; n < 2; ++n) _Pragma("unroll") for (int k = 0; k < 2; ++k) dst[n][k] = *(const PG8_LAS bf16x8*)(lds + PG8_SB(b, h) + boff + n * 2048 + k * 1024); } while (0)
#define PG8_MMA(ai, bj, At, Bt) do { __builtin_amdgcn_s_setprio(1); _Pragma("unroll") for (int m = 0; m < 4; ++m) _Pragma("unroll") for (int n = 0; n < 2; ++n) _Pragma("unroll") for (int k = 0; k < 2; ++k) \
        acc[ai][bj][m][n] = __builtin_amdgcn_mfma_f32_16x16x32_bf16(Bt[n][k], At[m][k], acc[ai][bj][m][n], 0, 0, 0); __builtin_amdgcn_s_setprio(0); } while (0)
#define PG8_WAIT_V(n) asm volatile("s_waitcnt vmcnt(" #n ")" ::: "memory")
#define PG8_WAIT_L(n) asm volatile("s_waitcnt lgkmcnt(" #n ")" ::: "memory")
#define PG8_BAR __builtin_amdgcn_s_barrier()
#define PG8_SCHED __builtin_amdgcn_sched_barrier(0)
    Unit cur, nxt; int ui = 0;
    if (!S.next(0, cur)) return;
    f32x4 acc[2][2][4][2];
#pragma unroll
    for (int a = 0; a < 2; ++a)
#pragma unroll
        for (int b = 0; b < 2; ++b)
#pragma unroll
            for (int m = 0; m < 4; ++m)
#pragma unroll
                for (int n = 0; n < 2; ++n) acc[a][b][m][n] = (f32x4){0.f, 0.f, 0.f, 0.f};
    bf16x8 At[4][2], B0[2][2], B1[2][2];
    const char* cA = (const char*)(cur.sel ? g.A2 : g.A) + (size_t)cur.pm * tstep; const char* cB = (const char*)(cur.sel ? g.Bt2 : g.Bt) + (size_t)cur.pn * tstep;
    S.a_ready(cur);
    if constexpr (SP2) {
        PG8_STAGE(PG8_SB(0, 0), cB, voffB); PG8_STAGE(PG8_SB(0, 1), cB + hstep, voffB); PG8_STAGE(PG8_SA(0, 0), cA, voffA); PG8_STAGE(PG8_SA(0, 1), cA + hstep, voffA);
        if (wr == 1) PG8_BAR;
        PG8_WAIT_V(2); PG8_BAR;
        PG8_STAGE(PG8_SB(1, 0), cB + kstep, voffB); PG8_STAGE(PG8_SA(1, 0), cA + kstep, voffA); PG8_STAGE(PG8_SB(1, 1), cB + hstep + kstep, voffB);
        PG8_WAIT_V(6); PG8_BAR;
    } else {
        PG8_STAGE(PG8_SB(0, 0), cB, voffB); PG8_STAGE(PG8_SA(0, 0), cA, voffA); PG8_STAGE(PG8_SB(0, 1), cB + hstep, voffB); PG8_STAGE(PG8_SA(0, 1), cA + hstep, voffA);
        if (wr == 1) PG8_BAR;
        PG8_WAIT_V(4); PG8_BAR;
        PG8_STAGE(PG8_SB(1, 0), cB + kstep, voffB); PG8_STAGE(PG8_SA(1, 0), cA + kstep, voffA); PG8_STAGE(PG8_SB(1, 1), cB + hstep + kstep, voffB);
        PG8_WAIT_V(6); PG8_BAR;
    }
    for (;;) {
        const bool has_next = S.next(ui + 1, nxt);
        unsigned pend = 0u; if constexpr (Sched::DYNAMIC) pend = S.claim_issue(wid, lane);
        const char* nA = has_next ? (const char*)(nxt.sel ? g.A2 : g.A) + (size_t)nxt.pm * tstep : cA; const char* nB = has_next ? (const char*)(nxt.sel ? g.Bt2 : g.Bt) + (size_t)nxt.pn * tstep : cB;
        for (int t = 0; t < nt; t += 2) {
            const bool last = (t == nt - 2);
            const char* a1 = cA + (size_t)(t + 1) * kstep;
            const char* a2 = last ? nA : cA + (size_t)(t + 2) * kstep; const char* b2 = last ? nB : cB + (size_t)(t + 2) * kstep;
            const char* a3 = a2 + kstep; const char* b3 = b2 + kstep;
            if (last && has_next) S.a_ready(nxt);
            if constexpr (SP2) {
            PG8_LDB(B0, 0, 0); PG8_LDB(B1, 0, 1); PG8_SCHED; PG8_LDA(At, 0, 0); PG8_STAGE(PG8_SA(1, 1), a1 + hstep, voffA);
            PG8_WAIT_V(8); PG8_WAIT_L(0); PG8_BAR; PG8_MMA(0, 0, At, B0); PG8_MMA(0, 1, At, B1); PG8_BAR; PG8_SCHED;
            PG8_LDA(At, 0, 1); PG8_STAGE(PG8_SB(0, 0), b2, voffB); PG8_STAGE(PG8_SB(0, 1), b2 + hstep, voffB); PG8_STAGE(PG8_SA(0, 0), a2, voffA);
            PG8_WAIT_V(8); PG8_WAIT_L(0); PG8_BAR; PG8_MMA(1, 0, At, B0); PG8_MMA(1, 1, At, B1); PG8_BAR; PG8_SCHED;
            PG8_LDB(B0, 1, 0); PG8_LDB(B1, 1, 1); PG8_SCHED; PG8_LDA(At, 1, 0); PG8_STAGE(PG8_SA(0, 1), a2 + hstep, voffA);
            PG8_WAIT_V(8); PG8_WAIT_L(0); PG8_BAR; PG8_MMA(0, 0, At, B0); PG8_MMA(0, 1, At, B1); PG8_BAR; PG8_SCHED;
            PG8_LDA(At, 1, 1); PG8_STAGE(PG8_SB(1, 0), b3, voffB); PG8_STAGE(PG8_SB(1, 1), b3 + hstep, voffB); PG8_STAGE(PG8_SA(1, 0), a3, voffA);
            PG8_WAIT_V(8); PG8_WAIT_L(0); PG8_BAR; PG8_MMA(1, 0, At, B0); PG8_MMA(1, 1, At, B1); PG8_BAR; PG8_SCHED;
            } else {
            PG8_LDB(B0, 0, 0); PG8_SCHED; PG8_LDA(At, 0, 0); PG8_STAGE(PG8_SA(1, 1), a1 + hstep, voffA);
            PG8_WAIT_L(8); PG8_BAR; PG8_WAIT_L(0); PG8_MMA(0, 0, At, B0); PG8_BAR; PG8_SCHED;
            PG8_LDB(B1, 0, 1); PG8_STAGE(PG8_SB(0, 0), b2, voffB);
            PG8_BAR; PG8_WAIT_L(0); PG8_MMA(0, 1, At, B1); PG8_BAR;
            PG8_LDA(At, 0, 1); PG8_STAGE(PG8_SA(0, 0), a2, voffA);
            PG8_BAR; PG8_WAIT_L(0); PG8_MMA(1, 0, At, B0); PG8_BAR; PG8_SCHED;
            PG8_STAGE(PG8_SB(0, 1), b2 + hstep, voffB);
            PG8_WAIT_V(6); PG8_BAR; PG8_MMA(1, 1, At, B1); PG8_BAR;
            PG8_LDB(B0, 1, 0); PG8_SCHED; PG8_LDA(At, 1, 0); PG8_STAGE(PG8_SA(0, 1), a2 + hstep, voffA);
            PG8_WAIT_L(8); PG8_BAR; PG8_WAIT_L(0); PG8_MMA(0, 0, At, B0); PG8_BAR; PG8_SCHED;
            PG8_LDB(B1, 1, 1); PG8_STAGE(PG8_SB(1, 0), b3, voffB);
            PG8_BAR; PG8_WAIT_L(0); PG8_MMA(0, 1, At, B1); PG8_BAR;
            PG8_LDA(At, 1, 1); PG8_STAGE(PG8_SA(1, 0), a3, voffA);
            PG8_BAR; PG8_WAIT_L(0); PG8_MMA(1, 0, At, B0); PG8_BAR; PG8_SCHED;
            PG8_STAGE(PG8_SB(1, 1), b3 + hstep, voffB);
            PG8_WAIT_V(6); PG8_BAR; PG8_MMA(1, 1, At, B1); PG8_BAR;
            }
        }
        if constexpr (Sched::DYNAMIC) { static_assert(!Sched::DYNAMIC || ALIGN_EPI, "dynamic orders publish in front of the ALIGN_EPI barrier"); S.claim_publish(ui + 2, pend, wid, lane); }
        if constexpr (ALIGN_EPI) { if (wr == 0) PG8_BAR; }
        if constexpr (!Epi::AFTER_DRAIN) { E(acc, cur, wr, wc, fr, fq); S.done(cur); }
        if (!has_next) break;
#pragma unroll
        for (int a = 0; a < 2; ++a)
#pragma unroll
            for (int b = 0; b < 2; ++b)
#pragma unroll
                for (int m = 0; m < 4; ++m)
#pragma unroll
                    for (int n = 0; n < 2; ++n) acc[a][b][m][n] = (f32x4){0.f, 0.f, 0.f, 0.f};
        cur = nxt; cA = nA; cB = nB; ++ui;
        if constexpr (ALIGN_EPI) { if (wr == 1) PG8_BAR; }
    }
    PG8_WAIT_V(0);
    if constexpr (!ALIGN_EPI) { if (wr == 0) PG8_BAR; }
    PG8_BAR;
    if constexpr (Epi::AFTER_DRAIN) { E.fused(acc, cur, wr, wc, fr, fq, lds, wid, lane); S.done(cur); }
#undef PG8_SA
#undef PG8_SB
#undef PG8_STAGE
#undef PG8_LDA
#undef PG8_LDB
#undef PG8_MMA
#undef PG8_WAIT_V
#undef PG8_WAIT_L
#undef PG8_BAR
#undef PG8_SCHED
}

template <class Epi, class Sched>
__device__ __forceinline__ void gemm_phase_gather(PG8_LAS unsigned char* lds, const Gemm g, const int* __restrict__ gidx, PG8_LAS int* itab  , const Sched& S, const Epi& E) {
    const int tid = threadIdx.x, wid = __builtin_amdgcn_readfirstlane(tid >> 6), lane = tid & 63, wr = wid >> 2, wc = wid & 3, fr = lane & 15, fq = lane >> 4;
    const int K = g.K, nt = K / BK;
    int RA[2], CA[2]; unsigned voffB[2];
#pragma unroll
    for (int i = 0; i < 2; ++i) { int R, C; stage_rc(tid * 16 + i * 8192, R, C); const int Rb = Epi::PERM ? ((R & ~31) + perm32(R & 31)) : R;
        RA[i] = R; CA[i] = C; voffB[i] = (unsigned)(Rb * K + C) * 2u; }
    const size_t kstep = (size_t)(BK * 2);
    const size_t hstep = (size_t)HALF * K * 2;
    const size_t tstep = 2 * hstep;
    const unsigned ldsw = (unsigned)wid * 1024u;
    const int aoff = lds_byte(wr * 64 + fr, fq * 8), boff = lds_byte(wc * 32 + fr, fq * 8);
#define PG8_SA(b, h) (((b) * 2 + (h)) * HTB)
#define PG8_SB(b, h) ((4 + (b) * 2 + (h)) * HTB)
#define PG8_STAGE(bufoff, gbase, voff) do { _Pragma("unroll") for (int _i = 0; _i < 2; ++_i) \
        __builtin_amdgcn_global_load_lds((const unsigned*)((const char*)(gbase) + (voff)[_i]), (PG8_LAS unsigned*)(lds + (bufoff) + ldsw + _i * 8192), 16, 0, 0); } while (0)
#define PG8_LDA(dst, b, h) do { _Pragma("unroll") for (int m = 0; m < 4; ++m) _Pragma("unroll") for (int k = 0; k < 2; ++k) dst[m][k] = *(const PG8_LAS bf16x8*)(lds + PG8_SA(b, h) + aoff + m * 2048 + k * 1024); } while (0)
#define PG8_LDB(dst, b, h) do { _Pragma("unroll") for (int n = 0; n < 2; ++n) _Pragma("unroll") for (int k = 0; k < 2; ++k) dst[n][k] = *(const PG8_LAS bf16x8*)(lds + PG8_SB(b, h) + boff + n * 2048 + k * 1024); } while (0)
#define PG8_MMA(ai, bj, At, Bt) do { __builtin_amdgcn_s_setprio(1); _Pragma("unroll") for (int m = 0; m < 4; ++m) _Pragma("unroll") for (int n = 0; n < 2; ++n) _Pragma("unroll") for (int k = 0; k < 2; ++k) \
        acc[ai][bj][m][n] = __builtin_amdgcn_mfma_f32_16x16x32_bf16(Bt[n][k], At[m][k], acc[ai][bj][m][n], 0, 0, 0); __builtin_amdgcn_s_setprio(0); } while (0)
#define PG8_WAIT_V(n) asm volatile("s_waitcnt vmcnt(" #n ")" ::: "memory")
#define PG8_WAIT_L(n) asm volatile("s_waitcnt lgkmcnt(" #n ")" ::: "memory")
#define PG8_BAR __builtin_amdgcn_s_barrier()
#define PG8_SCHED __builtin_amdgcn_sched_barrier(0)
#define PG8_GOFF(dst, ord) do { _Pragma("unroll") for (int _h = 0; _h < 2; ++_h) _Pragma("unroll") for (int _i = 0; _i < 2; ++_i) \
        dst[_h][_i] = ((unsigned)itab[(ord) * BM + _h * HALF + RA[_i]] * (unsigned)K + (unsigned)CA[_i]) * 2u; } while (0)
    { int vals[4];
#pragma unroll
      for (int k = 0; k < 4; ++k) { const int e = tid + 512 * k; Unit uu; const bool ok = S.next(e >> 8, uu); vals[k] = ok ? gidx[uu.pm * BM + (e & 255)] : 0; }
#pragma unroll
      for (int k = 0; k < 4; ++k) itab[tid + 512 * k] = vals[k];
      asm volatile("s_waitcnt vmcnt(0) lgkmcnt(0)" ::: "memory"); __builtin_amdgcn_s_barrier(); asm volatile("" ::: "memory"); }
    Unit cur, nxt; int ui = 0;
    if (!S.next(0, cur)) return;
    f32x4 acc[2][2][4][2];
#pragma unroll
    for (int a = 0; a < 2; ++a)
#pragma unroll
        for (int b = 0; b < 2; ++b)
#pragma unroll
            for (int m = 0; m < 4; ++m)
#pragma unroll
                for (int n = 0; n < 2; ++n) acc[a][b][m][n] = (f32x4){0.f, 0.f, 0.f, 0.f};
    bf16x8 At[4][2], B0[2][2], B1[2][2];
    const char* const gA = (const char*)g.A;
    unsigned cvo[2][2], nvo[2][2];
    PG8_GOFF(cvo, 0);
    const char* cB = (const char*)g.Bt + (size_t)cur.pn * tstep;
    S.a_ready(cur);
    PG8_STAGE(PG8_SB(0, 0), cB, voffB); PG8_STAGE(PG8_SB(0, 1), cB + hstep, voffB); PG8_STAGE(PG8_SA(0, 0), gA, cvo[0]); PG8_STAGE(PG8_SA(0, 1), gA, cvo[1]);
    if (wr == 1) PG8_BAR;
    PG8_WAIT_V(2); PG8_BAR;
    PG8_STAGE(PG8_SB(1, 0), cB + kstep, voffB); PG8_STAGE(PG8_SA(1, 0), gA + kstep, cvo[0]); PG8_STAGE(PG8_SB(1, 1), cB + hstep + kstep, voffB);
    PG8_WAIT_V(6); PG8_BAR;
    for (;;) {
        const bool has_next = S.next(ui + 1, nxt);
        if (has_next) { PG8_GOFF(nvo, ui + 1); } else {
#pragma unroll
            for (int _h = 0; _h < 2; ++_h)
#pragma unroll
                for (int _i = 0; _i < 2; ++_i) nvo[_h][_i] = cvo[_h][_i]; }
        const char* nB = has_next ? (const char*)g.Bt + (size_t)nxt.pn * tstep : cB;
        for (int t = 0; t < nt; t += 2) {
            const bool last = (t == nt - 2);
            const char* a1 = gA + (size_t)(t + 1) * kstep;
            const char* a2 = last ? gA : gA + (size_t)(t + 2) * kstep; const char* b2 = last ? nB : cB + (size_t)(t + 2) * kstep;
            const char* a3 = a2 + kstep; const char* b3 = b2 + kstep;
            unsigned vo2[2][2];
#pragma unroll
            for (int _h = 0; _h < 2; ++_h)
#pragma unroll
                for (int _i = 0; _i < 2; ++_i) vo2[_h][_i] = last ? nvo[_h][_i] : cvo[_h][_i];
            if (last && has_next) S.a_ready(nxt);
            PG8_LDB(B0, 0, 0); PG8_LDB(B1, 0, 1); PG8_SCHED; PG8_LDA(At, 0, 0); PG8_STAGE(PG8_SA(1, 1), a1, cvo[1]);
            PG8_WAIT_V(8); PG8_WAIT_L(0); PG8_BAR; PG8_MMA(0, 0, At, B0); PG8_MMA(0, 1, At, B1); PG8_BAR; PG8_SCHED;
            PG8_LDA(At, 0, 1); PG8_STAGE(PG8_SB(0, 0), b2, voffB); PG8_STAGE(PG8_SB(0, 1), b2 + hstep, voffB); PG8_STAGE(PG8_SA(0, 0), a2, vo2[0]);
            PG8_WAIT_V(8); PG8_WAIT_L(0); PG8_BAR; PG8_MMA(1, 0, At, B0); PG8_MMA(1, 1, At, B1); PG8_BAR; PG8_SCHED;
            PG8_LDB(B0, 1, 0); PG8_LDB(B1, 1, 1); PG8_SCHED; PG8_LDA(At, 1, 0); PG8_STAGE(PG8_SA(0, 1), a2, vo2[1]);
            PG8_WAIT_V(8); PG8_WAIT_L(0); PG8_BAR; PG8_MMA(0, 0, At, B0); PG8_MMA(0, 1, At, B1); PG8_BAR; PG8_SCHED;
            PG8_LDA(At, 1, 1); PG8_STAGE(PG8_SB(1, 0), b3, voffB); PG8_STAGE(PG8_SB(1, 1), b3 + hstep, voffB); PG8_STAGE(PG8_SA(1, 0), a3, vo2[0]);
            PG8_WAIT_V(8); PG8_WAIT_L(0); PG8_BAR; PG8_MMA(1, 0, At, B0); PG8_MMA(1, 1, At, B1); PG8_BAR; PG8_SCHED;
        }
        if (wr == 0) PG8_BAR;
        E(acc, cur, wr, wc, fr, fq); S.done(cur);
        if (!has_next) break;
#pragma unroll
        for (int a = 0; a < 2; ++a)
#pragma unroll
            for (int b = 0; b < 2; ++b)
#pragma unroll
                for (int m = 0; m < 4; ++m)
#pragma unroll
                    for (int n = 0; n < 2; ++n) acc[a][b][m][n] = (f32x4){0.f, 0.f, 0.f, 0.f};
        cur = nxt; cB = nB; ++ui;
#pragma unroll
        for (int _h = 0; _h < 2; ++_h)
#pragma unroll
            for (int _i = 0; _i < 2; ++_i) cvo[_h][_i] = nvo[_h][_i];
        if (wr == 1) PG8_BAR;
    }
    PG8_WAIT_V(0);
    PG8_BAR;
#undef PG8_GOFF
#undef PG8_SA
#undef PG8_SB
#undef PG8_STAGE
#undef PG8_LDA
#undef PG8_LDB
#undef PG8_MMA
#undef PG8_WAIT_V
#undef PG8_WAIT_L
#undef PG8_BAR
#undef PG8_SCHED
}
}

constexpr int NB = 4, SEQ = 4096, D = 2048, CTXL = 256;
constexpr int M = NB * SEQ;
constexpr int MC = NB * CTXL;
constexpr int MT = M + MC;
constexpr int NHEAD = 32, HD = 64, NGRP = 4, NST = 128;
constexpr int XBCW = 3072;
constexpr int PROJ_COLS = 15424;
constexpr int NPROJ_TILES = 61;
constexpr int NPROJ = NPROJ_TILES * 256;
constexpr int NE = 16, FF = 2048, CAP = 512;
constexpr int MODW = 6 * D;
constexpr float EPS = 1e-6f;

#ifndef MK_N_LAUNCHES
#define MK_N_LAUNCHES 1
#endif
constexpr int NPHASES = 13;
constexpr int NCHUNK = MT / 128;
constexpr int XTCH = 2560;

constexpr size_t MiB = 1u << 20;
constexpr size_t WS_CTL = 0, CTL_ZERO_BYTES = 1 * MiB;
constexpr size_t WS_MODX = 1 * MiB;
constexpr size_t WS_MODC = WS_MODX + 256 * 1024;
constexpr size_t WS_AFF = 2 * MiB;
constexpr size_t WS_SLOT = 3 * MiB;
constexpr size_t WS_IDX = 4 * MiB;
constexpr size_t WS_VAL = 4 * MiB + 512 * 1024;
constexpr size_t WS_DTS = 11 * MiB;
constexpr size_t WS_WSSD = 16 * MiB, WS_WSC = 24 * MiB, WS_WO = 32 * MiB;
constexpr size_t WS_G = 40 * MiB;
constexpr size_t WS_ACT = 40 * MiB;
constexpr size_t WS_SCY = 168 * MiB;
constexpr size_t WS_Z = 232 * MiB;
constexpr size_t WS_HX2 = WS_Z;
constexpr size_t WS_XBC = 296 * MiB;
constexpr size_t WS_MERGED = 296 * MiB;
constexpr size_t WS_OUTE = 296 * MiB;
constexpr size_t WS_XBCR = 392 * MiB;
constexpr size_t WS_HX = 398 * MiB;
constexpr size_t WS_WIN = 466 * MiB;
constexpr size_t WS_HENT = 398 * MiB;
constexpr size_t WS_OUTX = 398 * MiB;
constexpr size_t WS_ST = 527 * MiB;
constexpr size_t WS_Y = 527 * MiB;
constexpr size_t WS_CHLOG = 5 * MiB;
constexpr size_t WS_W13 = 663 * MiB;
constexpr size_t WS_W2 = 919 * MiB;
constexpr size_t WS_END = 1047 * MiB;
constexpr int CW_BAR = 4096;
constexpr int CW_Q0 = 64, CW_Q1 = 128, CW_Q2 = 192, CW_Q3 = 256, CW_Q4 = 320, CW_QG = 512  ;

constexpr int RING_BYTES = 131072;
constexpr int LDSCTL_OFF = 162816, MISC_OFF = LDSCTL_OFF + 320;
constexpr int LDS_BYTES = 163840;
constexpr int NWAVES = 8;

#define GAS __attribute__((address_space(1)))
#define LAS __attribute__((address_space(3)))
typedef unsigned short bf16;
typedef unsigned v4u __attribute__((ext_vector_type(4)));
typedef unsigned v2u __attribute__((ext_vector_type(2)));
typedef float f32x4 __attribute__((ext_vector_type(4)));
typedef float f32x16 __attribute__((ext_vector_type(16)));
typedef short bf16x8 __attribute__((ext_vector_type(8)));
#define LDS_WAIT() asm volatile("s_waitcnt lgkmcnt(0)" ::: "memory")
#define VM_WAIT() asm volatile("s_waitcnt vmcnt(0)" ::: "memory")
__device__ __forceinline__ unsigned pk2(float lo, float hi) { typedef float f2v __attribute__((ext_vector_type(2))); typedef __bf16 b2v __attribute__((ext_vector_type(2))); const f2v v = {lo, hi}; return __builtin_bit_cast(unsigned, __builtin_convertvector(v, b2v)); }
__device__ __forceinline__ float bflo(unsigned w) { return __builtin_bit_cast(float, w << 16); }
__device__ __forceinline__ float bfhi(unsigned w) { return __builtin_bit_cast(float, w & 0xffff0000u); }
__device__ __forceinline__ void unpack8(const v4u w, float (&o)[8]) { o[0] = bflo(w.x); o[1] = bfhi(w.x); o[2] = bflo(w.y); o[3] = bfhi(w.y); o[4] = bflo(w.z); o[5] = bfhi(w.z); o[6] = bflo(w.w); o[7] = bfhi(w.w); }
__device__ __forceinline__ v4u pack8(const float (&o)[8]) { v4u w; w.x = pk2(o[0], o[1]); w.y = pk2(o[2], o[3]); w.z = pk2(o[4], o[5]); w.w = pk2(o[6], o[7]); return w; }
__device__ __forceinline__ float siluf(float x) { return x * __builtin_amdgcn_rcpf(1.f + __expf(-x)); }
__device__ __forceinline__ float sigmf(float x) { return __builtin_amdgcn_rcpf(1.f + __expf(-x)); }
__device__ __forceinline__ float wave_sum(float v) {
#pragma unroll
    for (int o = 1; o < 64; o <<= 1) v += __shfl_xor(v, o);
    return v;
}

#define XB_TMO      128
#define XB_XCNT(j)  (256  + 64 * (j))
#define XB_XSUB(j)  (1280 + 64 * (j))
#define XB_XGEN(j)  (2304 + 64 * (j))
#define XB_TOP      3328
#define XB_TOPGEN   3392
#define XCD_BAR_WORDS 3456
#define XB_SPIN_CAP (1u << 18)

__device__ __forceinline__ unsigned xb_ld(unsigned* p)              { return __hip_atomic_load(p, __ATOMIC_RELAXED, __HIP_MEMORY_SCOPE_AGENT); }
__device__ __forceinline__ unsigned xb_add(unsigned* p, unsigned v) { return __hip_atomic_fetch_add(p, v, __ATOMIC_RELAXED, __HIP_MEMORY_SCOPE_AGENT); }
__device__ __forceinline__ unsigned xb_xcc_id() { return (unsigned)__builtin_amdgcn_s_getreg((3 << 11) | 20) & 0xFu; }
#define XB_SPIN(cond, bar) do { unsigned _sp = 0; while (cond) { __builtin_amdgcn_s_sleep(1); \
    if ((++_sp & 255u) == 0u) { if (xb_ld(&(bar)[XB_TMO])) break; if (_sp > XB_SPIN_CAP) { atomicAdd(&(bar)[XB_TMO], 1u); break; } } } } while (0)

struct XcdBarrier {
    unsigned* bar; unsigned x;
    volatile LAS unsigned* st;
};
__device__ __forceinline__ XcdBarrier xcd_barrier_post(unsigned* bar, volatile LAS unsigned* st) {
    XcdBarrier b; b.bar = bar; b.x = xb_xcc_id(); b.st = st;
    if (threadIdx.x == 0) (void)xb_add(&bar[XB_XCNT(b.x)], 1u);
    return b;
}
__device__ __forceinline__ void xcd_barrier_complete(unsigned* bar, unsigned x, unsigned& nloc, unsigned& nx) {
    const unsigned G = gridDim.x * gridDim.y * gridDim.z;
    unsigned sum, cnt, mine, sp = 0u;
    for (;;) {
        sum = 0u; cnt = 0u; mine = 0u;
#pragma unroll
        for (unsigned j = 0; j < 16; ++j) { const unsigned c = xb_ld(&bar[XB_XCNT(j)]); sum += c; cnt += (c > 0u) ? 1u : 0u; mine = (j == x) ? c : mine; }
        if (sum == G) break;
        __builtin_amdgcn_s_sleep(1);
        if ((++sp & 255u) == 0u) { if (xb_ld(&bar[XB_TMO])) break; if (sp > XB_SPIN_CAP) { atomicAdd(&bar[XB_TMO], 1u); break; } }
    }
    nloc = mine > 0u ? mine : 1u; nx = cnt > 0u ? cnt : 1u;
}
__device__ __forceinline__ void xcd_barrier(const XcdBarrier& b) {
    asm volatile("s_waitcnt vmcnt(0)" ::: "memory");
    __syncthreads();
    if (threadIdx.x == 0) {
        unsigned* bar = b.bar;
        __builtin_amdgcn_s_waitcnt(0);
        unsigned nloc = b.st[0], nx = b.st[1];
        if (nloc == 0u) { xcd_barrier_complete(bar, b.x, nloc, nx); b.st[0] = nloc; b.st[1] = nx; }
        const unsigned old = xb_add(&bar[XB_XSUB(b.x)], 1u);
        const unsigned gen = old / nloc;
        if (old + 1u == (gen + 1u) * nloc) {
            __builtin_amdgcn_fence(__ATOMIC_RELEASE, "agent");
            asm volatile("s_waitcnt vmcnt(0)" ::: "memory");
            const unsigned og = xb_add(&bar[XB_TOP], 1u);
            const unsigned tg = og / nx;
            if (og + 1u == (tg + 1u) * nx) xb_add(&bar[XB_TOPGEN], 1u);
            else XB_SPIN(xb_ld(&bar[XB_TOPGEN]) == tg, bar);
            __builtin_amdgcn_fence(__ATOMIC_ACQUIRE, "agent");
            xb_add(&bar[XB_XGEN(b.x)], 1u);
            asm volatile("s_waitcnt vmcnt(0)" ::: "memory");
        } else {
            XB_SPIN(xb_ld(&bar[XB_XGEN(b.x)]) == gen, bar);
            __builtin_amdgcn_fence(__ATOMIC_ACQUIRE, "agent");
            asm volatile("s_waitcnt vmcnt(0)" ::: "memory");
        }
    }
    __syncthreads();
}

struct WTile { const float* src; bf16* dst; const float* ksc; int ldw, ldk, perm; };
#define WTILE_STORE(T, v) do { \
    if ((T).ksc) { _Pragma("unroll") for (int j = 0; j < 16; ++j) v[j] = v[j] * (T).ksc[16 * kq + j]; } \
    const int drow_ = (T).perm ? 32 * (n4 >> 2) + 8 * (n4 & 3) : 4 * n4; \
    _Pragma("unroll") for (int q = 0; q < 4; ++q) { bf16* d = (T).dst + (size_t)(drow_ + q) * (T).ldk + 16 * kq; \
        v4u w0, w1; w0.x = pk2(v[0][q], v[1][q]); w0.y = pk2(v[2][q], v[3][q]); w0.z = pk2(v[4][q], v[5][q]); w0.w = pk2(v[6][q], v[7][q]); \
        w1.x = pk2(v[8][q], v[9][q]); w1.y = pk2(v[10][q], v[11][q]); w1.z = pk2(v[12][q], v[13][q]); w1.w = pk2(v[14][q], v[15][q]); \
        *(v4u*)d = w0; *(v4u*)(d + 8) = w1; } } while (0)
__device__ __forceinline__ void wtile_copy_pair(const WTile A, const WTile B, int lane) {
    const int n4 = lane & 15, kq = lane >> 4;
    f32x4 va[16], vb[16];
    { const float* s = A.src + (size_t)(16 * kq) * A.ldw + 4 * n4;
#pragma unroll
      for (int j = 0; j < 16; ++j) va[j] = __builtin_nontemporal_load((const f32x4*)(s + (size_t)j * A.ldw)); }
    { const float* s = B.src + (size_t)(16 * kq) * B.ldw + 4 * n4;
#pragma unroll
      for (int j = 0; j < 16; ++j) vb[j] = __builtin_nontemporal_load((const f32x4*)(s + (size_t)j * B.ldw)); }
    WTILE_STORE(A, va); WTILE_STORE(B, vb);
}
struct ExpertCopy { const float* w_e1; const float* w_e3; const float* w_e2; bf16* W13; bf16* W2; };
__device__ __forceinline__ WTile expert_tile_addr(const ExpertCopy& X, int it) {
    constexpr int I_SQ = 32 * 32;
    const int e = it / (3 * I_SQ); int r = it % (3 * I_SQ); const int which = r / I_SQ; r %= I_SQ; const int kb = r / 32, nb = r % 32, n0 = nb * 64, k0 = kb * 64;
    WTile t; t.ksc = nullptr; t.perm = 0;
    if (which == 0) { t.src = X.w_e1 + (size_t)e * D * FF + (size_t)k0 * FF + n0; t.ldw = FF; t.dst = X.W13 + (size_t)(e * 4096 + 256 * (n0 / 128) + (n0 % 128)) * D + k0; t.ldk = D; }
    else if (which == 1) { t.src = X.w_e3 + (size_t)e * D * FF + (size_t)k0 * FF + n0; t.ldw = FF; t.dst = X.W13 + (size_t)(e * 4096 + 256 * (n0 / 128) + 128 + (n0 % 128)) * D + k0; t.ldk = D; }
    else { t.src = X.w_e2 + (size_t)e * FF * D + (size_t)k0 * D + n0; t.ldw = D; t.dst = X.W2 + (size_t)(e * 2048 + n0) * FF + k0; t.ldk = FF; }
    return t;
}
#define WTILE_LOAD(T, v) do { const float* s_ = (T).src + (size_t)(16 * kq) * (T).ldw + 4 * n4; \
    _Pragma("unroll") for (int j = 0; j < 16; ++j) v[j] = __builtin_nontemporal_load((const f32x4*)(s_ + (size_t)j * (T).ldw)); } while (0)
__device__ __forceinline__ void expert_copy_share(const ExpertCopy& X, unsigned* qhead, int lane) {
    constexpr int NIT = NE * 3 * 32 * 32, GRP = 16;
    static_assert(FF == D && NIT % GRP == 0 && 32 % GRP == 0, "group addressing");
    const int n4 = lane & 15, kq = lane >> 4;
#pragma unroll 1
    for (;;) { int g0 = 0; if (lane == 0) g0 = (int)__hip_atomic_fetch_add(qhead, (unsigned)GRP, __ATOMIC_RELAXED, __HIP_MEMORY_SCOPE_AGENT);
        g0 = __builtin_amdgcn_readfirstlane(g0); if (g0 >= NIT) break;
        const WTile t0 = expert_tile_addr(X, g0); const bool w13 = (g0 / (32 * 32)) % 3 != 2;
        f32x4 va[16], vb[16];
        WTile ta = t0, tb = t0; tb.src = t0.src + 64; tb.dst = t0.dst + (size_t)64 * D;
        WTILE_LOAD(ta, va); WTILE_LOAD(tb, vb);
#pragma unroll
        for (int k = 0; k < GRP; k += 2) {
            __builtin_amdgcn_sched_barrier(0);
            WTILE_STORE(ta, va);
            if (k + 2 < GRP) { ta.src = t0.src + 64 * (k + 2); ta.dst = t0.dst + (size_t)(w13 ? 256 * ((k + 2) >> 1) : 64 * (k + 2)) * D; WTILE_LOAD(ta, va); }
            __builtin_amdgcn_sched_barrier(0);
            WTILE_STORE(tb, vb);
            if (k + 3 < GRP) { tb.src = t0.src + 64 * (k + 3); tb.dst = t0.dst + (size_t)(w13 ? 256 * ((k + 3) >> 1) + 64 : 64 * (k + 3)) * D; WTILE_LOAD(tb, vb); }
        }
    }
}
struct MixerCopy { const float* w_in; const float* w_ssd_out; const float* w_sc_out; const float* w_o; const float* ssd_norm_w; bf16* WIN; bf16* WSSD; bf16* WSC; bf16* WO; };
__device__ __forceinline__ WTile mixer_tile_addr(const MixerCopy& X, int it) {
    constexpr int I_IN = 32 * (PROJ_COLS / 64), I_SQ = 32 * 32;
    WTile t; t.ksc = nullptr; t.perm = 0;
    if (it < I_IN) { const int kb = it / (PROJ_COLS / 64), nb = it % (PROJ_COLS / 64), n0 = nb * 64, k0 = kb * 64; int vrow;
        if (n0 < 2048) { vrow = (12 + n0 / 64) * 256 + 128 + 4; t.perm = 1; }
        else if (n0 < 5120) vrow = n0 - 2048;
        else if (n0 < 5184) vrow = 60 * 256 + (n0 - 5120);
        else if (n0 < 7232) { vrow = (12 + (n0 - 5184) / 64) * 256; t.perm = 1; }
        else if (n0 < 9280) { vrow = (12 + (n0 - 7232) / 64) * 256 + 4; t.perm = 1; }
        else if (n0 < 11328) { vrow = (12 + (n0 - 9280) / 64) * 256 + 128; t.perm = 1; }
        else vrow = 44 * 256 + (n0 - 11328);
        t.src = X.w_in + (size_t)k0 * PROJ_COLS + n0; t.ldw = PROJ_COLS; t.dst = X.WIN + (size_t)vrow * D + k0; t.ldk = D; return t; }
    int r = it - I_IN; const int which = r / I_SQ; r %= I_SQ; const int kb = r / 32, nb = r % 32, n0 = nb * 64, k0 = kb * 64;
    const size_t so = (size_t)k0 * D + n0, dof = (size_t)n0 * D + k0; t.ldw = D; t.ldk = D;
    if (which == 0) { t.src = X.w_ssd_out + so; t.dst = X.WSSD + dof; t.ksc = X.ssd_norm_w + k0; }
    else if (which == 1) { t.src = X.w_sc_out + so; t.dst = X.WSC + dof; }
    else { t.src = X.w_o + so; t.dst = X.WO + dof; }
    return t;
}
struct OrderProj {
    static constexpr bool DYNAMIC = false;
    pg8::StaticOrder so; int G, c;
    __device__ __forceinline__ void init(int G_, int c_) { G = G_; c = c_; so.init(M, NPROJ, G_, c_); }
    __device__ __forceinline__ bool next(int i, pg8::Unit& u) const {
        const int L = i * G + c;
        if (L < 64 * NPROJ_TILES) return so.next(i, u);
        const int j = L - 64 * NPROJ_TILES; if (j >= 4 * 13) return false;
        u.pm = 64 + j / 13; const int k = j % 13; u.pn = k < 12 ? k : 60; return true;
    }
    __device__ __forceinline__ void a_ready(const pg8::Unit&) const {}
    __device__ __forceinline__ void done(const pg8::Unit&) const {}
};
struct OrderProjDyn {
    static constexpr bool DYNAMIC = true;
    unsigned* q; volatile LAS unsigned* slot; int x;
    __device__ __forceinline__ void init(unsigned* q0, volatile LAS unsigned* slot_, int c) { x = c & 7; q = q0 + 64 * x; slot = slot_;
        __syncthreads();
        if (threadIdx.x == 0) { const unsigned k = __hip_atomic_fetch_add(q, 2u, __ATOMIC_RELAXED, __HIP_MEMORY_SCOPE_AGENT); slot[0] = k; slot[1] = k + 1u; }
        __syncthreads(); }
    __device__ __forceinline__ bool next(int i, pg8::Unit& u) const {
        constexpr int QX = 64 * NPROJ_TILES / 8;
        const int k = __builtin_amdgcn_readfirstlane((int)slot[i & 3]);
        if (k < QX) { u.pm = 8 * x + (k & 7); u.pn = k >> 3; return true; }
        const int j = (k - QX) * 8 + x; if (j >= 4 * 13) return false;
        u.pm = 64 + j / 13; const int kk = j % 13; u.pn = kk < 12 ? kk : 60; return true;
    }
    __device__ __forceinline__ unsigned claim_issue(int wid, int lane) const { unsigned r = 0u; if (wid == 0 && lane == 0) { unsigned z; asm volatile("v_mov_b32 %0, 0" : "=v"(z)); r = __hip_atomic_fetch_add(q + z, 1u, __ATOMIC_RELAXED, __HIP_MEMORY_SCOPE_AGENT); } return r; }
    __device__ __forceinline__ void claim_publish(int i, unsigned r, int wid, int lane) const { const unsigned rr = __builtin_amdgcn_readfirstlane(r); if (lane == 0) slot[wid == 0 ? (i & 3) : 4 + wid] = rr; asm volatile("s_waitcnt lgkmcnt(0)" ::: "memory"); }
    __device__ __forceinline__ void a_ready(const pg8::Unit&) const {}
    __device__ __forceinline__ void done(const pg8::Unit&) const {}
};
template <int NJ> struct OrderMoe {
    static constexpr bool DYNAMIC = false;
    int G, c;
    __device__ __forceinline__ void init(int G_, int c_) { G = G_; c = c_; }
    __device__ __forceinline__ bool next(int i, pg8::Unit& u) const {
        constexpr int NWG = NE * 8 * NJ, Q = NWG / 8;
        const int L = i * G + c; if (L >= NWG) return false;
        const int wgid = (L % 8) * Q + L / 8;
        const int e = wgid / (8 * NJ), w = wgid % (8 * NJ), rt = w % 8, j = w / 8, b = rt >> 1, half = rt & 1;
        u.pm = (b * NE + e) * 2 + half; u.pn = e * NJ + j; return true;
    }
    __device__ __forceinline__ void a_ready(const pg8::Unit&) const {}
    __device__ __forceinline__ void done(const pg8::Unit&) const {}
};

struct OrderTwice {
    static constexpr bool DYNAMIC = false;
    pg8::StaticOrder so; int R;
    __device__ __forceinline__ bool next(int i, pg8::Unit& u) const { const int s = i >= R ? 1 : 0; const bool ok = so.next(i - s * R, u); u.sel = s; return ok && i < 2 * R; }
    __device__ __forceinline__ void a_ready(const pg8::Unit&) const {}
    __device__ __forceinline__ void done(const pg8::Unit&) const {}
};
using pg8::f32x4;
using pg8::u32x4;
__device__ __forceinline__ float softplusf(float x) { return x > 20.f ? x : log1pf(expf(x)); }
__device__ __forceinline__ float dpp_ror1(float v) { return __builtin_bit_cast(float, __builtin_amdgcn_update_dpp(0, __builtin_bit_cast(int, v), 0x121, 0xf, 0xf, false)); }
__device__ __forceinline__ float dpp_ror15(float v) { return __builtin_bit_cast(float, __builtin_amdgcn_update_dpp(0, __builtin_bit_cast(int, v), 0x12F, 0xf, 0xf, false)); }
struct EpiProj {
    static constexpr bool PERM = true, AFTER_DRAIN = false;
    bf16 *Z, *XBC, *XBCR, *SCY, *Gt; float* DTS; const float *cw, *cb, *scw, *dtb; const LAS float* scw_lds;
    __device__ __forceinline__ void operator()(const f32x4 (&acc)[2][2][4][2], const pg8::Unit& u, int wr, int wc, int fr, int fq_in) const {
        int fq = fq_in; asm volatile("" : "+v"(fq));
        const int row0 = u.pm * 256 + wr * 64 + fr; const int pn = u.pn;
        if (pn < 12) {
            const int col0 = pn * 256 + wc * 32 + 8 * fq;
            if (u.pm >= 64) {
#pragma unroll
                for (int ai = 0; ai < 2; ++ai)
#pragma unroll
                    for (int m = 0; m < 4; ++m) { bf16* rowp = XBCR + (size_t)(row0 - M + ai * 128 + m * 16) * XBCW + col0;
#pragma unroll
                        for (int bj = 0; bj < 2; ++bj) { const f32x4 v0 = acc[ai][bj][m][0], v1 = acc[ai][bj][m][1];
                            u32x4 w; w.x = pg8::cvt_pk_bf16(v0[0], v0[1]); w.y = pg8::cvt_pk_bf16(v0[2], v0[3]); w.z = pg8::cvt_pk_bf16(v1[0], v1[1]); w.w = pg8::cvt_pk_bf16(v1[2], v1[3]);
                            *(u32x4*)(rowp + bj * 128) = w; } }
            } else {
#pragma unroll
                for (int bj = 0; bj < 2; ++bj) {
                    const int col = col0 + bj * 128;
                    f32x4 w0[2], w1[2], w2[2], bb[2];
#pragma unroll
                    for (int n = 0; n < 2; ++n) { w0[n] = *(const f32x4*)(cw + col + 4 * n); w1[n] = *(const f32x4*)(cw + XBCW + col + 4 * n); w2[n] = *(const f32x4*)(cw + 2 * XBCW + col + 4 * n); bb[n] = *(const f32x4*)(cb + col + 4 * n); }
#pragma unroll
                    for (int ai = 0; ai < 2; ++ai) {
                        f32x4 o[4][2];
#pragma unroll
                        for (int n = 0; n < 2; ++n)
#pragma unroll
                            for (int q = 0; q < 4; ++q) { float A[4], B[4];
#pragma unroll
                                for (int m = 0; m < 4; ++m) { A[m] = dpp_ror1(acc[ai][bj][m][n][q]); B[m] = dpp_ror15(acc[ai][bj][m][n][q]); }
#pragma unroll
                                for (int m = 0; m < 4; ++m) { const float pv = fr > 0 ? A[m] : (m > 0 ? A[m > 0 ? m - 1 : 0] : 0.f), nv = fr < 15 ? B[m] : (m < 3 ? B[m < 3 ? m + 1 : 3] : 0.f);
                                    o[m][n][q] = siluf(bb[n][q] + w0[n][q] * pv + w1[n][q] * acc[ai][bj][m][n][q] + w2[n][q] * nv); } }
#pragma unroll
                        for (int m = 0; m < 4; ++m) { u32x4 w; w.x = pg8::cvt_pk_bf16(o[m][0][0], o[m][0][1]); w.y = pg8::cvt_pk_bf16(o[m][0][2], o[m][0][3]); w.z = pg8::cvt_pk_bf16(o[m][1][0], o[m][1][1]); w.w = pg8::cvt_pk_bf16(o[m][1][2], o[m][1][3]);
                            *(u32x4*)(XBC + (size_t)(row0 + ai * 128 + m * 16) * XBCW + col) = w; }
                    }
                }
            }
        } else if (pn < 44) {
            const int ch = (pn - 12) * 64 + wc * 16 + 4 * fq;
            const f32x4 w0 = *(const LAS f32x4*)(scw_lds + ch), w1 = *(const LAS f32x4*)(scw_lds + D + ch), w2 = *(const LAS f32x4*)(scw_lds + 2 * D + ch);
#pragma unroll
            for (int ai = 0; ai < 2; ++ai) {
                f32x4 cv[4];
#pragma unroll
                for (int m = 0; m < 4; ++m) cv[m] = acc[ai][0][m][1] * acc[ai][1][m][0];
                f32x4 o[4];
#pragma unroll
                for (int q = 0; q < 4; ++q) { float A[4], B[4];
#pragma unroll
                    for (int m = 0; m < 4; ++m) { A[m] = dpp_ror1(cv[m][q]); B[m] = dpp_ror15(cv[m][q]); }
#pragma unroll
                    for (int m = 0; m < 4; ++m) { const float pv = fr > 0 ? A[m] : (m > 0 ? A[m > 0 ? m - 1 : 0] : 0.f), nv = fr < 15 ? B[m] : (m < 3 ? B[m < 3 ? m + 1 : 3] : 0.f);
                        o[m][q] = acc[ai][0][m][0][q] * (w0[q] * pv + w1[q] * cv[m][q] + w2[q] * nv); } }
#pragma unroll
                for (int m = 0; m < 4; ++m) { const size_t row = (size_t)(row0 + ai * 128 + m * 16); const f32x4 zz = acc[ai][1][m][1];
                    v2u ws_; ws_.x = pg8::cvt_pk_bf16(o[m][0], o[m][1]); ws_.y = pg8::cvt_pk_bf16(o[m][2], o[m][3]); *(v2u*)(SCY + row * D + ch) = ws_;
                    v2u wz; wz.x = pg8::cvt_pk_bf16(zz[0], zz[1]); wz.y = pg8::cvt_pk_bf16(zz[2], zz[3]); *(v2u*)(Z + row * D + ch) = wz; }
            }
        } else if (pn < 60) {
            const int col0 = (pn - 44) * 256 + wc * 32 + 8 * fq;
#pragma unroll
            for (int ai = 0; ai < 2; ++ai)
#pragma unroll
                for (int m = 0; m < 4; ++m) { bf16* rowp = Gt + (size_t)(row0 + ai * 128 + m * 16) * (2 * D) + col0;
#pragma unroll
                    for (int bj = 0; bj < 2; ++bj) { const f32x4 v0 = acc[ai][bj][m][0], v1 = acc[ai][bj][m][1];
                        u32x4 w; w.x = pg8::cvt_pk_bf16(v0[0], v0[1]); w.y = pg8::cvt_pk_bf16(v0[2], v0[3]); w.z = pg8::cvt_pk_bf16(v1[0], v1[1]); w.w = pg8::cvt_pk_bf16(v1[2], v1[3]);
                        *(u32x4*)(rowp + bj * 128) = w; } }
        } else {
            if (wc < 2) {
                const int col0 = wc * 32 + 8 * fq; const f32x4 b0 = *(const f32x4*)(dtb + col0), b1 = *(const f32x4*)(dtb + col0 + 4);
#pragma unroll
                for (int ai = 0; ai < 2; ++ai)
#pragma unroll
                    for (int m = 0; m < 4; ++m) { float* rowp = DTS + (size_t)(row0 + ai * 128 + m * 16) * 64 + col0; f32x4 o0, o1;
#pragma unroll
                        for (int q = 0; q < 4; ++q) { o0[q] = softplusf(acc[ai][0][m][0][q] + b0[q]); o1[q] = softplusf(acc[ai][0][m][1][q] + b1[q]); }
                        *(f32x4*)(rowp) = o0; *(f32x4*)(rowp + 4) = o1; }
            }
        }
    }
};
struct EpiBf16Plain {
    static constexpr bool PERM = true, AFTER_DRAIN = false;
    bf16* O; int ldc;
    __device__ __forceinline__ void operator()(const f32x4 (&acc)[2][2][4][2], const pg8::Unit& u, int wr, int wc, int fr, int fq) const {
        const int row0 = u.pm * 256 + wr * 64 + fr, col0 = u.pn * 256 + wc * 32 + 8 * fq;
#pragma unroll
        for (int ai = 0; ai < 2; ++ai)
#pragma unroll
            for (int m = 0; m < 4; ++m) { bf16* rowp = O + (size_t)(row0 + ai * 128 + m * 16) * ldc + col0;
#pragma unroll
                for (int bj = 0; bj < 2; ++bj) { const f32x4 v0 = acc[ai][bj][m][0], v1 = acc[ai][bj][m][1];
                    u32x4 w; w.x = pg8::cvt_pk_bf16(v0[0], v0[1]); w.y = pg8::cvt_pk_bf16(v0[2], v0[3]); w.z = pg8::cvt_pk_bf16(v1[0], v1[1]); w.w = pg8::cvt_pk_bf16(v1[2], v1[3]);
                    *(u32x4*)(rowp + bj * 128) = w; } }
    }
};
struct EpiGate {
    static constexpr bool PERM = true, AFTER_DRAIN = false;
    const bf16* Gt; const float* bg; bf16* O;
    __device__ __forceinline__ void operator()(const f32x4 (&acc)[2][2][4][2], const pg8::Unit& u, int wr, int wc, int fr, int fq_in) const {
        int fq = fq_in; asm volatile("" : "+v"(fq));
        const int row0 = u.pm * 256 + wr * 64 + fr, col0 = u.pn * 256 + wc * 32 + 8 * fq; const bool first = u.sel == 0; const int goff = first ? 0 : D;
#pragma unroll
        for (int bj = 0; bj < 2; ++bj) {
            const int col = col0 + bj * 128;
            float b0[8];
            { const f32x4 t0 = *(const f32x4*)(bg + goff + col), t1 = *(const f32x4*)(bg + goff + col + 4);
#pragma unroll
              for (int q = 0; q < 4; ++q) { b0[q] = t0[q]; b0[4 + q] = t1[q]; } }
#pragma unroll
            for (int ai = 0; ai < 2; ++ai) {
                v4u gw_[4], pw_[4];
#pragma unroll
                for (int m = 0; m < 4; ++m) { const size_t row = (size_t)(row0 + ai * 128 + m * 16);
                    gw_[m] = *(const v4u*)(Gt + row * (2 * D) + goff + col); pw_[m] = first ? (v4u){0u, 0u, 0u, 0u} : *(const v4u*)(O + row * D + col); }
                __builtin_amdgcn_sched_barrier(0);
#pragma unroll
                for (int m = 0; m < 4; ++m) { const size_t row = (size_t)(row0 + ai * 128 + m * 16);
                    float g0[8], p[8]; unpack8(gw_[m], g0); unpack8(pw_[m], p);
                    float o[8];
#pragma unroll
                    for (int q = 0; q < 4; ++q) { o[q] = p[q] + sigmf(g0[q] + b0[q]) * acc[ai][bj][m][0][q]; o[4 + q] = p[4 + q] + sigmf(g0[4 + q] + b0[4 + q]) * acc[ai][bj][m][1][q]; }
                    *(v4u*)(O + row * D + col) = pack8(o); }
            }
        }
    }
};
struct EpiMoe1 {
    static constexpr bool PERM = true, AFTER_DRAIN = false;
    bf16* ACT;
    __device__ __forceinline__ void operator()(const f32x4 (&acc)[2][2][4][2], const pg8::Unit& u, int wr, int wc, int fr, int fq) const {
        const int row0 = u.pm * 256 + wr * 64 + fr, col0 = (u.pn & 15) * 128 + wc * 32 + 8 * fq;
#pragma unroll
        for (int ai = 0; ai < 2; ++ai)
#pragma unroll
            for (int m = 0; m < 4; ++m) { float o[8];
#pragma unroll
                for (int q = 0; q < 4; ++q) { o[q] = siluf(acc[ai][0][m][0][q]) * acc[ai][1][m][0][q]; o[4 + q] = siluf(acc[ai][0][m][1][q]) * acc[ai][1][m][1][q]; }
                *(v4u*)(ACT + (size_t)(row0 + ai * 128 + m * 16) * FF + col0) = pack8(o); }
    }
};
struct EpiMoe2 {
    static constexpr bool PERM = true, AFTER_DRAIN = false;
    bf16* O; const float* VAL;
    __device__ __forceinline__ void operator()(const f32x4 (&acc)[2][2][4][2], const pg8::Unit& u, int wr, int wc, int fr, int fq) const {
        const int row0 = u.pm * 256 + wr * 64 + fr, col0 = (u.pn & 7) * 256 + wc * 32 + 8 * fq;
        float sv[2][4];
#pragma unroll
        for (int ai = 0; ai < 2; ++ai)
#pragma unroll
            for (int m = 0; m < 4; ++m) sv[ai][m] = VAL[row0 + ai * 128 + m * 16];
#pragma unroll
        for (int ai = 0; ai < 2; ++ai)
#pragma unroll
            for (int m = 0; m < 4; ++m) { const int row = row0 + ai * 128 + m * 16; const float s = sv[ai][m]; bf16* rowp = O + (size_t)row * D + col0;
#pragma unroll
                for (int bj = 0; bj < 2; ++bj) { const f32x4 v0 = acc[ai][bj][m][0] * s, v1 = acc[ai][bj][m][1] * s;
                    v4u w; w.x = pk2(v0[0], v0[1]); w.y = pk2(v0[2], v0[3]); w.z = pk2(v1[0], v1[1]); w.w = pk2(v1[2], v1[3]);
                    *(v4u*)(rowp + bj * 128) = w; } }
    }
};

__device__ __forceinline__ v4u conv8r(const v4u cur, const v4u prv, const v4u nxt, const float* __restrict__ cw, const float* __restrict__ cb, int ch) {
    float c[8], p[8], n[8], o[8]; unpack8(cur, c); unpack8(prv, p); unpack8(nxt, n);
#pragma unroll
    for (int h4 = 0; h4 < 2; ++h4) { const f32x4 w0 = *(const f32x4*)(cw + ch + 4 * h4), w1 = *(const f32x4*)(cw + XBCW + ch + 4 * h4), w2 = *(const f32x4*)(cw + 2 * XBCW + ch + 4 * h4), bb = *(const f32x4*)(cb + ch + 4 * h4);
#pragma unroll
        for (int q = 0; q < 4; ++q) o[4 * h4 + q] = siluf(bb[q] + w0[q] * p[4 * h4 + q] + w1[q] * c[4 * h4 + q] + w2[q] * n[4 * h4 + q]); }
    return pack8(o);
}
__device__ __forceinline__ v4u conv8c(const bf16* __restrict__ XBCR, const float* __restrict__ cw, const float* __restrict__ cb, int rc, int ch) {
    const int pos = rc & 255; const bool hp = pos > 0, hn = pos < 255;
    const bf16* p = XBCR + (size_t)rc * XBCW + ch;
    const v4u cur = *(const v4u*)p; v4u prv = *(const v4u*)(hp ? p - XBCW : p), nxt = *(const v4u*)(hn ? p + XBCW : p);
    prv.x = hp ? prv.x : 0u; prv.y = hp ? prv.y : 0u; prv.z = hp ? prv.z : 0u; prv.w = hp ? prv.w : 0u;
    nxt.x = hn ? nxt.x : 0u; nxt.y = hn ? nxt.y : 0u; nxt.z = hn ? nxt.z : 0u; nxt.w = hn ? nxt.w : 0u;
    return conv8r(cur, prv, nxt, cw, cb, ch);
}
typedef short v4i16_t __attribute__((ext_vector_type(4)));
__device__ __forceinline__ v2u tr_read(const LAS unsigned char* p) { return __builtin_bit_cast(v2u, __builtin_amdgcn_ds_read_tr16_b64_v4i16((LAS v4i16_t*)p)); }

__device__ __forceinline__ int claim_item(unsigned* qhead, volatile LAS unsigned* slot) {
    __syncthreads();
    if (threadIdx.x == 0) *slot = __hip_atomic_fetch_add(qhead, 1u, __ATOMIC_RELAXED, __HIP_MEMORY_SCOPE_AGENT);
    __syncthreads();
    return (int)*slot;
}
struct Args { const float* in[26]; float* out; unsigned char* ws; int ph_lo, ph_hi; };
static_assert(sizeof(Args) == 26 * 8 + 8 + 8 + 8, "Args has no padding");

__global__ void __launch_bounds__(NWAVES * 64, 2) mk_fwd(Args args) {
    extern __shared__ __attribute__((aligned(16))) unsigned char lds_raw[];
    LAS unsigned char* lds = (LAS unsigned char*)lds_raw;
    volatile LAS unsigned* MISC = (volatile LAS unsigned*)(lds + MISC_OFF);
    const int tid = threadIdx.x, lane = tid & 63, wave = __builtin_amdgcn_readfirstlane(tid >> 6);
    const int G = gridDim.x, bx = blockIdx.x;
    const int gw = bx * NWAVES + wave, NGW = G * NWAVES;
    const size_t gtid = (size_t)bx * (NWAVES * 64) + tid, NGT = (size_t)G * (NWAVES * 64);
    unsigned* ctl = (unsigned*)(args.ws + WS_CTL);

#define KAS __attribute__((address_space(4)))
#define PHASE_BASES() const KAS char* KA = (const KAS char*)__builtin_amdgcn_kernarg_segment_ptr(); asm volatile("" : "+s"(KA)); unsigned char* const ws = *(unsigned char* const KAS*)(KA + 8 * 27)
#define KARG(k) (*(const float* const KAS*)(KA + 8 * (k)))
#define in_x KARG(0)
#define cvec KARG(1)
#define ctx KARG(2)
#define c_ctx KARG(3)
#define w_mod KARG(4)
#define b_mod KARG(5)
#define n_pre_mix KARG(6)
#define n_post_mix KARG(7)
#define w_in KARG(8)
#define ssd_conv_w KARG(9)
#define ssd_conv_b KARG(10)
#define dt_bias KARG(11)
#define a_log KARG(12)
#define ssd_d KARG(13)
#define ssd_norm_w KARG(14)
#define w_ssd_out KARG(15)
#define sc_conv_w KARG(16)
#define w_sc_out KARG(17)
#define b_gate KARG(18)
#define w_o KARG(19)
#define n_pre_ffn KARG(20)
#define n_post_ffn KARG(21)
#define w_router KARG(22)
#define w_e1 KARG(23)
#define w_e3 KARG(24)
#define w_e2 KARG(25)
#define out (*(float* const KAS*)(KA + 8 * 26))
#define MODX ((float*)(ws + WS_MODX))
#define MODC ((float*)(ws + WS_MODC))
#define AFF ((float*)(ws + WS_AFF))
#define SLOT ((int*)(ws + WS_SLOT))
#define IDX ((int*)(ws + WS_IDX))
#define VAL ((float*)(ws + WS_VAL))
#define DTS ((float*)(ws + WS_DTS))
#define WIN ((bf16*)(ws + WS_WIN))
#define WSSD ((bf16*)(ws + WS_WSSD))
#define WSC ((bf16*)(ws + WS_WSC))
#define WO ((bf16*)(ws + WS_WO))
#define HX ((bf16*)(ws + WS_HX))
#define Zb ((bf16*)(ws + WS_Z))
#define XBC ((bf16*)(ws + WS_XBC))
#define XBCR ((bf16*)(ws + WS_XBCR))
#define Gt ((bf16*)(ws + WS_G))
#define SCY ((bf16*)(ws + WS_SCY))
#define ST ((bf16*)(ws + WS_ST))
#define HENT ((bf16*)(ws + WS_HENT))
#define CHLOG ((float*)(ws + WS_CHLOG))
#define Yn ((bf16*)(ws + WS_Y))
#define MERGED ((bf16*)(ws + WS_MERGED))
#define OUTX ((bf16*)(ws + WS_OUTX))
#define HX2 ((bf16*)(ws + WS_HX2))
#define W13 ((bf16*)(ws + WS_W13))
#define W2 ((bf16*)(ws + WS_W2))
#define ACT ((bf16*)(ws + WS_ACT))
#define OUTE ((bf16*)(ws + WS_OUTE))
    for (int u = tid; u < (LDS_BYTES - LDSCTL_OFF) / 4; u += NWAVES * 64) ((LAS unsigned*)(lds + LDSCTL_OFF))[u] = 0u;
    __syncthreads();
    XcdBarrier bar; bar.bar = ctl + CW_BAR; bar.x = 0; bar.st = nullptr;
    if (MK_N_LAUNCHES == 1) bar = xcd_barrier_post(ctl + CW_BAR, MISC + 8);
#define GRID_BAR() do { if (MK_N_LAUNCHES == 1) xcd_barrier(bar); } while (0)
    const int lo = args.ph_lo, hi = args.ph_hi;
#ifndef PH_MASK
#define PH_MASK 0xFFFFFFFFu
#endif
#define IN(k) (((PH_MASK >> (k)) & 1u) && lo <= (k) && (k) < hi)
#define BOTH(k) (IN(k) && IN((k) + 1))

    if (IN(0)) { PHASE_BASES();
        for (int bi = bx; bi < MODW / 128; bi += G) {
            LAS float* sl = (LAS float*)lds;
            LAS float* red = (LAS float*)(lds + 5 * 2048 * 4);
            for (int i = tid; i < 5 * D; i += NWAVES * 64) { const int r = i / D, k = i % D; const float v = r < 4 ? cvec[r * D + k] : c_ctx[k]; sl[i] = siluf(v); }
            __syncthreads();
            const int c4 = lane & 31, kh = lane >> 5;
            f32x4 a0 = {0.f, 0.f, 0.f, 0.f}, a1 = a0, a2 = a0, a3 = a0, a4 = a0;
            const float* wp = w_mod + (size_t)(wave * 256 + kh) * MODW + bi * 128 + 4 * c4;
#pragma unroll 1
            for (int k0 = 0; k0 < 128; k0 += 32) { f32x4 wv[32];
#pragma unroll
                for (int u = 0; u < 32; ++u) wv[u] = __builtin_nontemporal_load((const f32x4*)(wp + (size_t)(2 * (k0 + u)) * MODW));
#pragma unroll
                for (int u = 0; u < 32; ++u) { const int k = wave * 256 + 2 * (k0 + u) + kh;
                    a0 += wv[u] * sl[k]; a1 += wv[u] * sl[D + k]; a2 += wv[u] * sl[2 * D + k]; a3 += wv[u] * sl[3 * D + k]; a4 += wv[u] * sl[4 * D + k]; } }
#pragma unroll
            for (int q = 0; q < 4; ++q) { a0[q] += __shfl_xor(a0[q], 32); a1[q] += __shfl_xor(a1[q], 32); a2[q] += __shfl_xor(a2[q], 32); a3[q] += __shfl_xor(a3[q], 32); a4[q] += __shfl_xor(a4[q], 32); }
            if (kh == 0) { *(LAS f32x4*)(red + (wave * 5 + 0) * 128 + 4 * c4) = a0; *(LAS f32x4*)(red + (wave * 5 + 1) * 128 + 4 * c4) = a1; *(LAS f32x4*)(red + (wave * 5 + 2) * 128 + 4 * c4) = a2;
                           *(LAS f32x4*)(red + (wave * 5 + 3) * 128 + 4 * c4) = a3; *(LAS f32x4*)(red + (wave * 5 + 4) * 128 + 4 * c4) = a4; }
            __syncthreads();
            for (int i = tid; i < 5 * 128; i += NWAVES * 64) { const int r = i >> 7, l = i & 127; float sacc = 0.f;
#pragma unroll
                for (int w = 0; w < 8; ++w) sacc += red[(w * 5 + r) * 128 + l];
                const int cc = bi * 128 + l; sacc += b_mod[cc]; if (r < 4) MODX[r * MODW + cc] = sacc; else MODC[cc] = sacc; }
            __syncthreads();
        }
        { constexpr int NIT = 32 * (PROJ_COLS / 64);
          static_assert(NIT % 8 == 0, "claims of 8");
          const MixerCopy X{w_in, w_ssd_out, w_sc_out, w_o, ssd_norm_w, WIN, WSSD, WSC, WO};
#pragma unroll 1
          for (;;) { int g0 = 0; if (lane == 0) g0 = (int)__hip_atomic_fetch_add(ctl + CW_Q0, 8u, __ATOMIC_RELAXED, __HIP_MEMORY_SCOPE_AGENT);
              g0 = __builtin_amdgcn_readfirstlane(g0); if (g0 >= NIT) break;
#pragma unroll 1
              for (int k = 0; k < 8; k += 2) wtile_copy_pair(mixer_tile_addr(X, g0 + k), mixer_tile_addr(X, g0 + k + 1), lane); } }
        { v4u* zp = (v4u*)(WIN + (size_t)15424 * D); const size_t nz = (size_t)192 * D * 2 / 16; for (size_t i = gtid; i < nz; i += NGT) zp[i] = (v4u){0u, 0u, 0u, 0u}; }
        if (BOTH(0)) GRID_BAR();
    }

    if (IN(1)) { PHASE_BASES();
        f32x4 pg[8];
#pragma unroll
        for (int j = 0; j < 8; ++j) pg[j] = ((const f32x4*)n_pre_mix)[lane + 64 * j];
        f32x4 ps1[8], ps0[8]; int bcur = -1;
        for (int row = gw; row < MT; row += NGW) {
            const float* src; const float* sh; const float* sc; int b;
            if (row < M) { b = row / SEQ; src = in_x + (size_t)row * D; sh = MODX + b * MODW; sc = sh + D; }
            else { b = NB; src = ctx + (size_t)(row - M) * D; sh = MODC; sc = MODC + D; }
            f32x4 v[8]; float ss = 0.f;
#pragma unroll
            for (int j = 0; j < 8; ++j) v[j] = __builtin_nontemporal_load((const f32x4*)src + lane + 64 * j);
            if (b != bcur) { bcur = b;
#pragma unroll
                for (int j = 0; j < 8; ++j) { ps1[j] = ((const f32x4*)sc)[lane + 64 * j]; ps0[j] = ((const f32x4*)sh)[lane + 64 * j]; } }
#pragma unroll
            for (int j = 0; j < 8; ++j) ss += (v[j].x * v[j].x + v[j].y * v[j].y) + (v[j].z * v[j].z + v[j].w * v[j].w);
            const float rstd = 1.0f / sqrtf(wave_sum(ss) * (1.f / D) + EPS);
            v2u* o8 = (v2u*)(HX + (size_t)row * D) + lane;
#pragma unroll
            for (int j = 0; j < 8; ++j) { const f32x4 o = (v[j] * rstd * pg[j]) * (ps1[j] + 1.0f) + ps0[j]; v2u w; w.x = pk2(o.x, o.y); w.y = pk2(o.z, o.w); o8[64 * j] = w; }
        }
        if (BOTH(1)) GRID_BAR();
    }

    if (IN(2)) { PHASE_BASES();
        if ((((bx >> 3) & 15) < 3) || (bx >> 3) == 8) {
            { constexpr int I_IN = 32 * (PROJ_COLS / 64), NIT = I_IN + 3 * 32 * 32;
              const MixerCopy Xm{w_in, w_ssd_out, w_sc_out, w_o, ssd_norm_w, WIN, WSSD, WSC, WO};
#pragma unroll 1
              for (;;) { int g0 = 0; if (lane == 0) g0 = I_IN + (int)__hip_atomic_fetch_add(ctl + CW_Q4, 8u, __ATOMIC_RELAXED, __HIP_MEMORY_SCOPE_AGENT);
                  g0 = __builtin_amdgcn_readfirstlane(g0); if (g0 >= NIT) break;
#pragma unroll 1
                  for (int k = 0; k < 8; k += 2) wtile_copy_pair(mixer_tile_addr(Xm, g0 + k), mixer_tile_addr(Xm, g0 + k + 1), lane); } }
            const ExpertCopy X{w_e1, w_e3, w_e2, W13, W2}; expert_copy_share(X, ctl + CW_Q1, lane); }
        pg8::Gemm g{HX, WIN, MT, NPROJ, D}; OrderProjDyn S; S.init(ctl + CW_QG, MISC + 24, bx);
        { LAS f32x4* sw = (LAS f32x4*)(lds + 131072);
          for (int i4 = tid; i4 < 3 * D / 4; i4 += NWAVES * 64) sw[i4] = ((const f32x4*)sc_conv_w)[i4];
          __syncthreads(); }
        EpiProj E{Zb, XBC, XBCR, SCY, Gt, DTS, ssd_conv_w, ssd_conv_b, sc_conv_w, dt_bias, (const LAS float*)(lds + 131072)};
        pg8::gemm_phase<EpiProj, OrderProjDyn, true, true>(lds, g, S, E);
        if (BOTH(2)) GRID_BAR();
    }

    if (IN(3)) { PHASE_BASES();
        LAS unsigned char* sBt = lds;
        LAS unsigned char* sXt = lds + 40960;
        LAS float* sW = (LAS float*)(lds + 40960 + 73728) + wave * 128;
        const int r32 = lane & 31, hh = lane >> 5, hl = wave >> 1, dir = wave & 1;
        const int li = lane & 15, tq = li >> 2, tp = li & 3, blk = (lane >> 4) & 1;
        volatile LAS unsigned* qs = MISC + 40;
        __syncthreads();
        if (tid == 0) { const unsigned a0 = __hip_atomic_fetch_add(ctl + CW_Q2, 2u, __ATOMIC_RELAXED, __HIP_MEMORY_SCOPE_AGENT); qs[0] = a0; qs[1] = a0 + 1u; }
        __syncthreads();
#define P3_MAP(q) ((q) < 128 ? (((q) & 1) ? ((q) >> 1) : NCHUNK * 8 - 64 + ((q) >> 1)) : ((q) < NCHUNK * 8 ? (q) - 64 : NCHUNK * 8))
        int item = P3_MAP((int)qs[0]), trip = 0;
        v4u pB[4], pX[8]; float pd0 = 0.f, pd1 = 0.f;
#define P3_REQUEST(itm) do { const int cg_ = (itm) >> 3, grp_ = ((itm) >> 1) & 3, hq_ = (itm) & 1, head_ = grp_ * 8 + hq_ * 4 + hl, row0_ = cg_ * 128; int t1_ = tid; asm volatile("" : "+v"(t1_)); \
            _Pragma("unroll") for (int m = 0; m < 4; ++m) { const int q = t1_ + 512 * m, tok = q >> 4, ck = q & 15; pB[m] = *(const v4u*)(XBC + (size_t)(row0_ + tok) * XBCW + 2048 + grp_ * 128 + ck * 8); } \
            _Pragma("unroll") for (int m = 0; m < 8; ++m) { const int q = t1_ + 512 * m, tok = q >> 5, ck = q & 31; pX[m] = *(const v4u*)(XBC + (size_t)(row0_ + tok) * XBCW + grp_ * 512 + hq_ * 256 + ck * 8); } \
            { const int ln_ = t1_ & 63; pd0 = DTS[(size_t)(row0_ + 2 * ln_) * 64 + dir * 32 + head_]; pd1 = DTS[(size_t)(row0_ + 2 * ln_ + 1) * 64 + dir * 32 + head_]; } } while (0)
        if (item < NCHUNK * 8 && (item >> 3) < 128) P3_REQUEST(item);
        while (item < NCHUNK * 8) {
            const int cg = item >> 3, grp = (item >> 1) & 3, hq = item & 1, head = grp * 8 + hq * 4 + hl, row0 = cg * 128;
            __syncthreads();
            const int nq = (int)qs[(trip + 1) & 3]; const int nitem = P3_MAP(nq);
            unsigned pend = 0u;
            if (tid == 0) { unsigned z; asm volatile("v_mov_b32 %0, 0" : "=v"(z)); pend = __hip_atomic_fetch_add(ctl + CW_Q2 + z, 1u, __ATOMIC_RELAXED, __HIP_MEMORY_SCOPE_AGENT); }
            int t1 = tid; asm volatile("" : "+v"(t1));
            float d0, d1;
            if (cg < 128) {
#pragma unroll
                for (int m = 0; m < 4; ++m) { const int q = t1 + 512 * m, tok = q >> 4, ck = q & 15; *(LAS v4u*)(sBt + tok * 320 + ck * 16) = pB[m]; }
#pragma unroll
                for (int m = 0; m < 8; ++m) { const int q = t1 + 512 * m, tok = q >> 5, ck = q & 31; *(LAS v4u*)(sXt + tok * 576 + ck * 16) = pX[m]; }
                d0 = pd0; d1 = pd1;
            } else {
                { const int ln = t1 & 63; d0 = DTS[(size_t)(row0 + 2 * ln) * 64 + dir * 32 + head]; d1 = DTS[(size_t)(row0 + 2 * ln + 1) * 64 + dir * 32 + head]; }
                { v4u rc_[4], rp_[4], rn_[4];
#pragma unroll
                  for (int m = 0; m < 4; ++m) { const int q = t1 + 512 * m, tok = q >> 4, ck = q & 15, rr_ = row0 - M + tok, pos = rr_ & 255; const bf16* p = XBCR + (size_t)rr_ * XBCW + 2048 + grp * 128 + ck * 8;
                      rc_[m] = *(const v4u*)p; rp_[m] = *(const v4u*)(pos > 0 ? p - XBCW : p); rn_[m] = *(const v4u*)(pos < 255 ? p + XBCW : p); }
#pragma unroll
                  for (int m = 0; m < 4; ++m) { const int q = t1 + 512 * m, tok = q >> 4, ck = q & 15, pos = (row0 - M + tok) & 255; const bool hp = pos > 0, hn = pos < 255;
                      v4u pv_ = rp_[m], nv_ = rn_[m]; pv_.x = hp ? pv_.x : 0u; pv_.y = hp ? pv_.y : 0u; pv_.z = hp ? pv_.z : 0u; pv_.w = hp ? pv_.w : 0u; nv_.x = hn ? nv_.x : 0u; nv_.y = hn ? nv_.y : 0u; nv_.z = hn ? nv_.z : 0u; nv_.w = hn ? nv_.w : 0u;
                      *(LAS v4u*)(sBt + tok * 320 + ck * 16) = conv8r(rc_[m], pv_, nv_, ssd_conv_w, ssd_conv_b, 2048 + grp * 128 + ck * 8); } }
                { v4u rc_[8], rp_[8], rn_[8];
#pragma unroll
                  for (int m = 0; m < 8; ++m) { const int q = t1 + 512 * m, tok = q >> 5, ck = q & 31, rr_ = row0 - M + tok, pos = rr_ & 255; const bf16* p = XBCR + (size_t)rr_ * XBCW + grp * 512 + hq * 256 + ck * 8;
                      rc_[m] = *(const v4u*)p; rp_[m] = *(const v4u*)(pos > 0 ? p - XBCW : p); rn_[m] = *(const v4u*)(pos < 255 ? p + XBCW : p); }
#pragma unroll
                  for (int m = 0; m < 8; ++m) { const int q = t1 + 512 * m, tok = q >> 5, ck = q & 31, pos = (row0 - M + tok) & 255; const bool hp = pos > 0, hn = pos < 255;
                      v4u pv_ = rp_[m], nv_ = rn_[m]; pv_.x = hp ? pv_.x : 0u; pv_.y = hp ? pv_.y : 0u; pv_.z = hp ? pv_.z : 0u; pv_.w = hp ? pv_.w : 0u; nv_.x = hn ? nv_.x : 0u; nv_.y = hn ? nv_.y : 0u; nv_.z = hn ? nv_.z : 0u; nv_.w = hn ? nv_.w : 0u;
                      *(LAS v4u*)(sXt + tok * 576 + ck * 16) = conv8r(rc_[m], pv_, nv_, ssd_conv_w, ssd_conv_b, grp * 512 + hq * 256 + ck * 8); } }
            }
            { int ln = t1 & 63;
              const float a = -expf(a_log[dir * 32 + head]); const float v0 = a * d0, v1 = a * d1;
              float inc = v0 + v1;
#pragma unroll
              for (int o = 1; o < 64; o <<= 1) { const float t = __shfl_up(inc, o); if (ln >= o) inc += t; }
              const float tot = __shfl(inc, 63), ex = inc - (v0 + v1);
              const float w0 = dir ? expf(ex) * d0 : expf(tot - (ex + v0)) * d0, w1 = dir ? expf(ex + v0) * d1 : expf(tot - (ex + v0 + v1)) * d1;
              sW[2 * ln] = w0; sW[2 * ln + 1] = w1;
              if (ln == 0) CHLOG[(cg * 2 + dir) * 32 + head] = tot; }
            __syncthreads();
            if (nitem < NCHUNK * 8 && (nitem >> 3) < 128) P3_REQUEST(nitem);
            __builtin_amdgcn_sched_barrier(0);
            f32x16 acc[4][2];
#pragma unroll
            for (int nt = 0; nt < 4; ++nt)
#pragma unroll
                for (int pt = 0; pt < 2; ++pt)
#pragma unroll
                    for (int k = 0; k < 16; ++k) acc[nt][pt][k] = 0.f;
            const LAS unsigned char* xrd = sXt + (8 * hh + tq) * 576 + (hl * 64 + 16 * blk + 4 * tp) * 2;
            const LAS unsigned char* brd = sBt + (8 * hh + tq) * 320 + (16 * blk + 4 * tp) * 2;
#pragma unroll 2
            for (int s = 0; s < 8; ++s) {
                const f32x4 w0 = *(const LAS f32x4*)(sW + 16 * s + 8 * hh), w1 = *(const LAS f32x4*)(sW + 16 * s + 8 * hh + 4);
                bf16x8 xf[2];
#pragma unroll
                for (int pt = 0; pt < 2; ++pt) { const v2u lo = tr_read(xrd + (16 * s) * 576 + 64 * pt), hi = tr_read(xrd + (16 * s + 4) * 576 + 64 * pt);
                    float t[8] = {bflo(lo.x) * w0[0], bfhi(lo.x) * w0[1], bflo(lo.y) * w0[2], bfhi(lo.y) * w0[3], bflo(hi.x) * w1[0], bfhi(hi.x) * w1[1], bflo(hi.y) * w1[2], bfhi(hi.y) * w1[3]};
                    xf[pt] = __builtin_bit_cast(bf16x8, pack8(t)); }
#pragma unroll
                for (int nt = 0; nt < 4; ++nt) { const v2u lo = tr_read(brd + (16 * s) * 320 + 64 * nt), hi = tr_read(brd + (16 * s + 4) * 320 + 64 * nt);
                    v4u bw; bw.x = lo.x; bw.y = lo.y; bw.z = hi.x; bw.w = hi.y; const bf16x8 bfm = __builtin_bit_cast(bf16x8, bw);
#pragma unroll
                    for (int pt = 0; pt < 2; ++pt) acc[nt][pt] = __builtin_amdgcn_mfma_f32_32x32x16_bf16(bfm, xf[pt], acc[nt][pt], 0, 0, 0); }
            }
            __syncthreads();
            if (tid == 0) qs[(trip + 2) & 3] = pend;
            { LAS unsigned char* sS = lds + wave * 16896;
#pragma unroll
              for (int nt = 0; nt < 4; ++nt)
#pragma unroll
                  for (int pt = 0; pt < 2; ++pt)
#pragma unroll
                      for (int gq = 0; gq < 4; ++gq) { v2u w; w.x = pk2(acc[nt][pt][4 * gq], acc[nt][pt][4 * gq + 1]); w.y = pk2(acc[nt][pt][4 * gq + 2], acc[nt][pt][4 * gq + 3]);
                          *(LAS v2u*)(sS + (32 * pt + r32) * 264 + (32 * nt + 8 * gq + 4 * hh) * 2) = w; }
              LDS_WAIT(); asm volatile("" ::: "memory");
              bf16* stp = ST + ((size_t)(cg * 2 + dir) * 32 + head) * 8192;
#pragma unroll
              for (int k = 0; k < 16; ++k) { const int p = 4 * k + (lane >> 4), c16 = lane & 15;
                  const LAS unsigned char* src = sS + p * 264 + c16 * 16; v4u v; v.x = *(const LAS unsigned*)src; v.y = *(const LAS unsigned*)(src + 4); v.z = *(const LAS unsigned*)(src + 8); v.w = *(const LAS unsigned*)(src + 12);
                  *(v4u*)(stp + p * 128 + c16 * 8) = v; } }
            item = nitem; ++trip;
        }
#undef P3_REQUEST
#undef P3_MAP
        __syncthreads();
        if (BOTH(3)) GRID_BAR();
    }

    if (IN(4)) { PHASE_BASES();
        for (int item = bx; item < NB * NHEAD * 2; item += G) {
            const int b = item >> 6, head = (item >> 1) & 31, dir = item & 1;
#define P4_CG(st) (dir == 0 ? ((st) < 2 ? 128 + 2 * b + (st) : 32 * b + ((st) - 2)) : ((st) < 2 ? 128 + 2 * b + 1 - (st) : 32 * b + 31 - ((st) - 2)))
#define P4_BASE(st) (((size_t)(P4_CG(st) * 2 + dir) * 32 + head) * 8192)
            float decv = 0.f; { const int st = lane < 34 ? lane : 33; decv = expf(CHLOG[(P4_CG(st) * 2 + dir) * 32 + head]); }
            float h[16];
#pragma unroll
            for (int k = 0; k < 16; ++k) h[k] = 0.f;
            v4u r0[4], r1[4];
#pragma unroll
            for (int k = 0; k < 4; ++k) { const size_t base = P4_BASE(k); r0[k] = __builtin_nontemporal_load((const v4u*)(ST + base + tid * 8)); r1[k] = __builtin_nontemporal_load((const v4u*)(ST + base + 4096 + tid * 8)); }
#pragma unroll
            for (int step = 0; step < 34; ++step) {
                const size_t base = P4_BASE(step);
                const float dec = __shfl(decv, step);
                float s0[8], s1[8]; unpack8(r0[step & 3], s0); unpack8(r1[step & 3], s1);
                if (step + 4 < 34) { const size_t nb_ = P4_BASE(step + 4); r0[step & 3] = __builtin_nontemporal_load((const v4u*)(ST + nb_ + tid * 8)); r1[step & 3] = __builtin_nontemporal_load((const v4u*)(ST + nb_ + 4096 + tid * 8)); }
                if (step >= 2) { float t0[8], t1[8];
#pragma unroll
                    for (int k = 0; k < 8; ++k) { t0[k] = h[k]; t1[k] = h[8 + k]; }
                    *(v4u*)(HENT + base + tid * 8) = pack8(t0); *(v4u*)(HENT + base + 4096 + tid * 8) = pack8(t1); }
#pragma unroll
                for (int k = 0; k < 8; ++k) { h[k] = dec * h[k] + s0[k]; h[8 + k] = dec * h[8 + k] + s1[k]; }
            }
#undef P4_CG
#undef P4_BASE
        }
        if (BOTH(4)) GRID_BAR();
    }

    if (IN(5)) { PHASE_BASES();
        LAS unsigned char* sBt = lds;
        LAS unsigned char* sCz = lds + 34816;
        LAS unsigned char* sHF = lds + 69632;
        LAS unsigned char* sHB = lds + 87040;
        LAS unsigned char* sX = lds + 104448;
        LAS float* sTab0 = (LAS float*)(lds + 129024);
        LAS float* SSQ = (LAS float*)(lds + 137216);
        LAS unsigned char* sY = lds + 138240;
        const int r32 = lane & 31, hh = lane >> 5, it = wave & 3, pt = wave >> 2, i = 32 * it + r32;
        const int li = lane & 15, tq = li >> 2, tp = li & 3, blk = (lane >> 4) & 1;
        for (int item = claim_item(ctl + CW_Q3, MISC + 17); item < 128 * 4; item = claim_item(ctl + CW_Q3, MISC + 17)) {
            const int cg = item >> 2, grp = item & 3, row0 = cg * 128;
            __syncthreads();
            int t1 = tid; asm volatile("" : "+v"(t1));
            v4u zr0[2];
#pragma unroll
            for (int m = 0; m < 2; ++m) { const int q = t1 + 512 * m, tok = q >> 3, ck = q & 7; zr0[m] = *(const v4u*)(Zb + (size_t)(row0 + tok) * D + (grp * 8) * 64 + ck * 8); }
#pragma unroll
            for (int m = 0; m < 4; ++m) { const int q = t1 + 512 * m, tok = q >> 4, ck = q & 15;
                *(LAS v4u*)(sBt + tok * 272 + ck * 16) = *(const v4u*)(XBC + (size_t)(row0 + tok) * XBCW + 2048 + grp * 128 + ck * 8);
                *(LAS v4u*)(sCz + tok * 272 + ck * 16) = *(const v4u*)(XBC + (size_t)(row0 + tok) * XBCW + 2560 + grp * 128 + ck * 8); }
            { const int head = grp * 8;
#pragma unroll
              for (int m = 0; m < 4; ++m) { const int q = t1 + 512 * m, which = q >> 10, r = (q & 1023) >> 4, ck = q & 15;
                  *(LAS v4u*)(sHF + which * 17408 + r * 272 + ck * 16) = __builtin_nontemporal_load((const v4u*)(HENT + ((size_t)(cg * 2 + which) * 32 + head) * 8192 + r * 128 + ck * 8)); }
#pragma unroll
              for (int m = 0; m < 2; ++m) { const int q = t1 + 512 * m, tok = q >> 3, ck = q & 7;
                  *(LAS v4u*)(sX + tok * 192 + ck * 16) = *(const v4u*)(XBC + (size_t)(row0 + tok) * XBCW + head * 64 + ck * 8); } }
            float tAF0, tAF1, tAB0, tAB1, tDF0, tDF1, tDB0, tDB1;
            { const int head = grp * 8 + wave; int ln = t1 & 63;
              const float dF0 = DTS[(size_t)(row0 + 2 * ln) * 64 + head], dF1 = DTS[(size_t)(row0 + 2 * ln + 1) * 64 + head];
              const float dB0 = DTS[(size_t)(row0 + 2 * ln) * 64 + 32 + head], dB1 = DTS[(size_t)(row0 + 2 * ln + 1) * 64 + 32 + head];
              const float aF = -expf(a_log[head]), aB = -expf(a_log[32 + head]);
              const float vF0 = aF * dF0, vF1 = aF * dF1, vB0 = aB * dB0, vB1 = aB * dB1;
              float inF = vF0 + vF1, inB = vB0 + vB1;
#pragma unroll
              for (int o = 1; o < 64; o <<= 1) { const float tF = __shfl_up(inF, o), tB = __shfl_up(inB, o); if (ln >= o) { inF += tF; inB += tB; } }
              const float totB = __shfl(inB, 63);
              const float exF = inF - (vF0 + vF1), exB = inB - (vB0 + vB1);
              tAF0 = exF + vF0; tAF1 = exF + vF0 + vF1;
              tAB0 = totB - exB; tAB1 = totB - (exB + vB0);
              tDF0 = dF0; tDF1 = dF1; tDB0 = dB0; tDB1 = dB1; }
#define P6_WRITE_TABLES(hdx) do { int ln = (int)(threadIdx.x & 63u); asm volatile("" : "+v"(ln)); LAS float* sTab = sTab0 + ((hdx) & 1) * 1024; LAS float* sArr = sTab + 512; \
            sArr[2 * ln] = tAF0; sArr[2 * ln + 1] = tAF1; sArr[128 + 2 * ln] = tAB0; sArr[128 + 2 * ln + 1] = tAB1; \
            sArr[256 + 2 * ln] = tDF0; sArr[256 + 2 * ln + 1] = tDF1; sArr[384 + 2 * ln] = tDB0; sArr[384 + 2 * ln + 1] = tDB1; \
            _Pragma("unroll") for (int tt = 0; tt < 4; ++tt) { const float refF = __shfl(tAF0, 16 * tt), refB = __shfl(tAB1, 16 * tt + 15); const int j0 = 2 * ln; \
                sTab[tt * 128 + j0]     = j0 < 32 * tt     ? __expf(refF - tAF0) * tDF0 : (j0 >= 32 * tt + 32     ? __expf(refB - tAB0) * tDB0 : 0.f); \
                sTab[tt * 128 + j0 + 1] = j0 + 1 < 32 * tt ? __expf(refF - tAF1) * tDF1 : (j0 + 1 >= 32 * tt + 32 ? __expf(refB - tAB1) * tDB1 : 0.f); } } while (0)
            if (wave == 0) P6_WRITE_TABLES(0);
            __syncthreads();
            f32x16 G[4];
            { bf16x8 cf[8];
#pragma unroll
            for (int s = 0; s < 8; ++s) cf[s] = *(const LAS bf16x8*)(sCz + i * 272 + 32 * s + 16 * hh);
            { const LAS unsigned char* pBg = sBt + r32 * 272 + 16 * hh; asm volatile("" : "+v"(pBg));
#pragma unroll
              for (int jt = 0; jt < 4; ++jt) {
#pragma unroll
                  for (int k = 0; k < 16; ++k) G[jt][k] = 0.f;
#pragma unroll
                  for (int s = 0; s < 8; ++s) G[jt] = __builtin_amdgcn_mfma_f32_32x32x16_bf16(*(const LAS bf16x8*)(pBg + (32 * jt) * 272 + 32 * s), cf[s], G[jt], 0, 0, 0); } } }
            __syncthreads();
#pragma unroll
            for (int m = 0; m < 2; ++m) { const int q = t1 + 512 * m, tok = q >> 3, ck = q & 7; *(LAS v4u*)(sBt + tok * 192 + ck * 16) = zr0[m]; }
            __syncthreads();
            float ssq_acc = 0.f;
            const float Dv8 = ssd_d[grp * 8 + (lane & 7)];
#pragma unroll 1
            for (int hd = 0; hd < 8; ++hd) {
                const int head = grp * 8 + hd;
                int t2 = tid; asm volatile("" : "+v"(t2));
                int iv = r32; asm volatile("" : "+v"(iv));
                if (wave == hd + 1) P6_WRITE_TABLES(hd + 1);
                const LAS float* sTab = sTab0 + (hd & 1) * 1024; const LAS float* sArr = sTab + 512;
                v4u pfh[4], pfz[2], pxc[2];
                if (hd < 7) {
#pragma unroll
                    for (int m = 0; m < 4; ++m) { const int q = t2 + 512 * m, which = q >> 10, r = (q & 1023) >> 4, ck = q & 15;
                        pfh[m] = __builtin_nontemporal_load((const v4u*)(HENT + ((size_t)(cg * 2 + which) * 32 + head + 1) * 8192 + r * 128 + ck * 8)); }
#pragma unroll
                    for (int m = 0; m < 2; ++m) { const int q = t2 + 512 * m, tok = q >> 3, ck = q & 7; const size_t r = (size_t)(row0 + tok);
                        pfz[m] = __builtin_nontemporal_load((const v4u*)(Zb + r * D + (head + 1) * 64 + ck * 8)); pxc[m] = __builtin_nontemporal_load((const v4u*)(XBC + r * XBCW + (head + 1) * 64 + ck * 8)); } }
                __builtin_amdgcn_sched_barrier(0);
                const LAS unsigned char* pHF = sHF + (32 * pt + r32) * 272 + 16 * hh; asm volatile("" : "+v"(pHF));
                const LAS unsigned char* pHB = sHB + (32 * pt + r32) * 272 + 16 * hh; asm volatile("" : "+v"(pHB));
                const LAS unsigned char* pCf = sCz + i * 272 + 16 * hh; asm volatile("" : "+v"(pCf));
                const LAS float* pTab = sTab + it * 128 + 4 * hh; asm volatile("" : "+v"(pTab));
                const LAS float* pArr = sArr + 4 * hh; asm volatile("" : "+v"(pArr));
                const LAS float* pArrI = sArr + i; asm volatile("" : "+v"(pArrI));
                const LAS float* pArrT = sArr + 32 * it; asm volatile("" : "+v"(pArrT));
                const LAS unsigned char* pXi = sX + i * 192 + 64 * pt + 8 * hh; asm volatile("" : "+v"(pXi));
                const LAS unsigned char* pZi = sBt + i * 192 + 64 * pt + 8 * hh; asm volatile("" : "+v"(pZi));
                const float aFi = pArrI[0], aBi = pArrI[128];
                const float eF = expf(aFi), eB = expf(aBi), rowF = __expf(aFi - pArrT[0]), rowB = __expf(aBi - pArrT[128 + 31]);
                f32x16 acc, tL;
#pragma unroll
                for (int k = 0; k < 16; ++k) { acc[k] = 0.f; tL[k] = 0.f; }
#pragma unroll
                for (int s = 0; s < 8; ++s) { const bf16x8 cfs = *(const LAS bf16x8*)(pCf + 32 * s);
                    acc = __builtin_amdgcn_mfma_f32_32x32x16_bf16(*(const LAS bf16x8*)(pHF + 32 * s), cfs, acc, 0, 0, 0);
                    tL = __builtin_amdgcn_mfma_f32_32x32x16_bf16(*(const LAS bf16x8*)(pHB + 32 * s), cfs, tL, 0, 0, 0); }
#pragma unroll
                for (int k = 0; k < 16; ++k) { acc[k] = acc[k] * eF + tL[k] * eB; tL[k] = 0.f; }
                const LAS unsigned char* xrd = sX + (4 * hh + tq) * 192 + (32 * pt + 16 * blk + 4 * tp) * 2; asm volatile("" : "+v"(xrd));
#pragma unroll
                for (int jt = 0; jt < 4; ++jt) {
                    __builtin_amdgcn_sched_barrier(0);
                    f32x16 Xf = G[jt];
                    if (jt != it) {
#pragma unroll
                        for (int gq = 0; gq < 4; ++gq) { const f32x4 T = *(const LAS f32x4*)(pTab + 32 * jt + 8 * gq);
#pragma unroll
                            for (int q = 0; q < 4; ++q) Xf[4 * gq + q] *= T[q]; }
                    } else {
#pragma unroll
                        for (int gq = 0; gq < 4; ++gq) { const int jl0 = 8 * gq + 4 * hh;
                            const f32x4 AF = *(const LAS f32x4*)(pArr + 32 * jt + 8 * gq), AB = *(const LAS f32x4*)(pArr + 128 + 32 * jt + 8 * gq), DF = *(const LAS f32x4*)(pArr + 256 + 32 * jt + 8 * gq), DB = *(const LAS f32x4*)(pArr + 384 + 32 * jt + 8 * gq);
#pragma unroll
                            for (int q = 0; q < 4; ++q) { const int jl = jl0 + q; const bool lower = jl < iv;
                                const float arg = lower ? aFi - AF[q] : aBi - AB[q]; float f = __expf(arg) * (lower ? DF[q] : DB[q]); f += (jl == iv) ? DF[q] : 0.f;
                                Xf[4 * gq + q] *= f; } }
                    }
                    bf16x8 mf[2], xa[2];
#pragma unroll
                    for (int ss = 0; ss < 2; ++ss) { v4u w; w.x = pk2(Xf[8 * ss + 0], Xf[8 * ss + 1]); w.y = pk2(Xf[8 * ss + 2], Xf[8 * ss + 3]); w.z = pk2(Xf[8 * ss + 4], Xf[8 * ss + 5]); w.w = pk2(Xf[8 * ss + 6], Xf[8 * ss + 7]);
                        mf[ss] = __builtin_bit_cast(bf16x8, w);
                        const v2u lo = tr_read(xrd + (32 * jt + 16 * ss) * 192), hi = tr_read(xrd + (32 * jt + 16 * ss + 8) * 192); v4u xw; xw.x = lo.x; xw.y = lo.y; xw.z = hi.x; xw.w = hi.y;
                        xa[ss] = __builtin_bit_cast(bf16x8, xw); }
                    if (jt != it) { tL = __builtin_amdgcn_mfma_f32_32x32x16_bf16(xa[0], mf[0], tL, 0, 0, 0); tL = __builtin_amdgcn_mfma_f32_32x32x16_bf16(xa[1], mf[1], tL, 0, 0, 0); }
                    else {
#pragma unroll
                        for (int k = 0; k < 16; ++k) { acc[k] += rowF * tL[k]; tL[k] = 0.f; }
                        acc = __builtin_amdgcn_mfma_f32_32x32x16_bf16(xa[0], mf[0], acc, 0, 0, 0); acc = __builtin_amdgcn_mfma_f32_32x32x16_bf16(xa[1], mf[1], acc, 0, 0, 0); }
                }
#pragma unroll
                for (int k = 0; k < 16; ++k) acc[k] += rowB * tL[k];
                {
                    const float Dh = __shfl(Dv8, hd);
                    LAS unsigned char* pY = sY + i * 128; asm volatile("" : "+v"(pY));
#pragma unroll
                    for (int gq = 0; gq < 4; ++gq) {
                        const v2u xw = *(const LAS v2u*)(pXi + 16 * gq), zw = *(const LAS v2u*)(pZi + 16 * gq);
                        const float xv[4] = {bflo(xw.x), bfhi(xw.x), bflo(xw.y), bfhi(xw.y)}, zv[4] = {bflo(zw.x), bfhi(zw.x), bflo(zw.y), bfhi(zw.y)};
                        float y[4];
#pragma unroll
                        for (int q = 0; q < 4; ++q) { y[q] = (acc[4 * gq + q] + Dh * xv[q]) * siluf(zv[q]); ssq_acc += y[q] * y[q]; }
                        v2u w; w.x = pk2(y[0], y[1]); w.y = pk2(y[2], y[3]);
                        *(LAS v2u*)(pY + (((8 * pt + 2 * gq + hh) ^ (iv & 15)) << 3)) = w; }
                }
                __syncthreads();
                { const int tok = t2 >> 2, c16 = t2 & 3; const LAS unsigned char* src = sY + tok * 128; v2u c[4];
#pragma unroll
                  for (int k = 0; k < 4; ++k) c[k] = *(const LAS v2u*)(src + (((4 * c16 + k) ^ (tok & 15)) << 3));
                  bf16* dst = Yn + (size_t)(row0 + tok) * D + head * 64 + 16 * c16;
                  v4u w0; w0.x = c[0].x; w0.y = c[0].y; w0.z = c[1].x; w0.w = c[1].y; v4u w1; w1.x = c[2].x; w1.y = c[2].y; w1.z = c[3].x; w1.w = c[3].y;
                  *(v4u*)dst = w0; *(v4u*)(dst + 8) = w1; }
                if (hd < 7) {
#pragma unroll
                    for (int m = 0; m < 4; ++m) { const int q = t2 + 512 * m, which = q >> 10, r = (q & 1023) >> 4, ck = q & 15;
                        *(LAS v4u*)(sHF + which * 17408 + r * 272 + ck * 16) = pfh[m]; }
#pragma unroll
                    for (int m = 0; m < 2; ++m) { const int q = t2 + 512 * m, tok = q >> 3, ck = q & 7;
                        *(LAS v4u*)(sBt + tok * 192 + ck * 16) = pfz[m];
                        *(LAS v4u*)(sX + tok * 192 + ck * 16) = pxc[m]; }
                }
                __syncthreads();
            }
#undef P6_WRITE_TABLES
            ssq_acc += __shfl_xor(ssq_acc, 32);
            if (lane < 32) SSQ[pt * 128 + i] = ssq_acc;
            VM_WAIT();
            __syncthreads();
            {
                v4u wv[16];
                bf16* yb = Yn + (size_t)(row0 + wave * 16) * D + grp * 512 + lane * 8;
#pragma unroll
                for (int r = 0; r < 16; ++r) wv[r] = *(const v4u*)(yb + (size_t)r * D);
#pragma unroll
                for (int r = 0; r < 16; ++r) { const float tot = SSQ[wave * 16 + r] + SSQ[128 + wave * 16 + r];
                    const float rstd = 1.0f / sqrtf(tot * (1.f / 512.f) + EPS);
                    float t[8]; unpack8(wv[r], t);
#pragma unroll
                    for (int e = 0; e < 8; ++e) t[e] *= rstd;
                    *(v4u*)(yb + (size_t)r * D) = pack8(t); }
            }
        }
        __syncthreads();
        if (BOTH(5)) GRID_BAR();
    }

    if (IN(6)) { PHASE_BASES();
        { pg8::Gemm g{Yn, WSSD, M, D, D, SCY, WSC}; OrderTwice S; S.so.init(M, D, G, bx); S.R = (512 + G - 1) / G; EpiGate E{Gt, b_gate, MERGED};
          pg8::gemm_phase<EpiGate, OrderTwice, true, true>(lds, g, S, E); }
        if (BOTH(6)) GRID_BAR();
    }

    if (IN(7)) { PHASE_BASES();
        pg8::Gemm g{MERGED, WO, M, D, D}; pg8::StaticOrder S; S.init(M, D, G, bx); EpiBf16Plain E{OUTX, D};
        pg8::gemm_phase<EpiBf16Plain, pg8::StaticOrder, true, true>(lds, g, S, E);
        if (BOTH(7)) GRID_BAR();
    }

    if (IN(8)) { PHASE_BASES();
        LAS float* wrT = (LAS float*)lds;
        for (int ch = tid; ch < D; ch += NWAVES * 64) { f32x4 wv[4];
#pragma unroll
            for (int q = 0; q < 4; ++q) wv[q] = ((const f32x4*)(w_router + (size_t)ch * NE))[q];
#pragma unroll
            for (int q = 0; q < 4; ++q) { wrT[(4 * q + 0) * D + ch] = wv[q].x; wrT[(4 * q + 1) * D + ch] = wv[q].y; wrT[(4 * q + 2) * D + ch] = wv[q].z; wrT[(4 * q + 3) * D + ch] = wv[q].w; } }
        __syncthreads();
        LAS f32x4* pv = (LAS f32x4*)(lds + 131072);
        for (int trip = 0; trip * 2 * NGW < M; ++trip) {
            const int row0 = 2 * gw + trip * 2 * NGW; const int b = (16 * bx + trip * 2 * NGW) / SEQ;
            __syncthreads();
            { const float* md = MODX + b * MODW;
              for (int c4 = tid; c4 < D / 4; c4 += NWAVES * 64) { const f32x4 gpm = ((const f32x4*)n_post_mix)[c4], gx = ((const f32x4*)(md + 2 * D))[c4], gpf = ((const f32x4*)n_pre_ffn)[c4], s0 = ((const f32x4*)(md + 3 * D))[c4], s1 = ((const f32x4*)(md + 4 * D))[c4];
                  pv[c4] = gx * gpm; pv[D / 4 + c4] = gpf * (s1 + 1.0f); pv[2 * (D / 4) + c4] = s0; } }
            __syncthreads();
            if (row0 >= M) continue;
            f32x4 va[8], vb[8];
            v2u owa[8], owb[8]; f32x4 xra[8], xrb[8];
#pragma unroll
            for (int j = 0; j < 8; ++j) { owa[j] = __builtin_nontemporal_load((const v2u*)(OUTX + (size_t)row0 * D) + lane + 64 * j); owb[j] = __builtin_nontemporal_load((const v2u*)(OUTX + (size_t)(row0 + 1) * D) + lane + 64 * j); }
#pragma unroll
            for (int j = 0; j < 8; ++j) { xra[j] = __builtin_nontemporal_load((const f32x4*)(in_x + (size_t)row0 * D) + lane + 64 * j); xrb[j] = __builtin_nontemporal_load((const f32x4*)(in_x + (size_t)(row0 + 1) * D) + lane + 64 * j); }
#pragma unroll
            for (int rr = 0; rr < 2; ++rr) {
                const int row = row0 + rr; f32x4 v[8]; float ss = 0.f;
#pragma unroll
                for (int j = 0; j < 8; ++j) { const v2u ow = rr ? owb[j] : owa[j]; v[j] = (f32x4){bflo(ow.x), bfhi(ow.x), bflo(ow.y), bfhi(ow.y)}; ss += (v[j].x * v[j].x + v[j].y * v[j].y) + (v[j].z * v[j].z + v[j].w * v[j].w); }
                const float rstd1 = 1.0f / sqrtf(wave_sum(ss) * (1.f / D) + EPS);
                float ss2 = 0.f;
#pragma unroll
                for (int j = 0; j < 8; ++j) { const f32x4 xr = rr ? xrb[j] : xra[j], a1 = pv[lane + 64 * j];
                    v[j] = xr + a1 * (v[j] * rstd1); ((f32x4*)(out + (size_t)row * D))[lane + 64 * j] = v[j];
                    ss2 += (v[j].x * v[j].x + v[j].y * v[j].y) + (v[j].z * v[j].z + v[j].w * v[j].w); }
                const float rstd2 = 1.0f / sqrtf(wave_sum(ss2) * (1.f / D) + EPS);
                v2u* o8 = (v2u*)(HX2 + (size_t)row * D) + lane;
#pragma unroll
                for (int j = 0; j < 8; ++j) { const f32x4 a2 = pv[D / 4 + lane + 64 * j], a3 = pv[2 * (D / 4) + lane + 64 * j];
                    v[j] = (v[j] * rstd2) * a2 + a3; v2u w; w.x = pk2(v[j].x, v[j].y); w.y = pk2(v[j].z, v[j].w); o8[64 * j] = w;
                    if (rr == 0) va[j] = v[j]; else vb[j] = v[j]; }
            }
            float q8a[8], q8b[8];
            const bool h5 = (lane & 32) != 0, h4 = (lane & 16) != 0, h3 = (lane & 8) != 0, h2 = (lane & 4) != 0;
#pragma unroll
            for (int e = 0; e < 8; ++e) {
                pg8::f32x2 pa0 = {0.f, 0.f}, pb0 = pa0, pa1 = pa0, pb1 = pa0;
                { __builtin_amdgcn_sched_barrier(0);
                  f32x4 w0[8];
#pragma unroll
                  for (int j = 0; j < 8; ++j) w0[j] = ((const LAS f32x4*)(wrT + e * D))[lane + 64 * j];
#pragma unroll
                  for (int j = 0; j < 8; ++j) {
                    pa0 = __builtin_elementwise_fma(va[j].xy, w0[j].xy, pa0); pa0 = __builtin_elementwise_fma(va[j].zw, w0[j].zw, pa0);
                    pb0 = __builtin_elementwise_fma(vb[j].xy, w0[j].xy, pb0); pb0 = __builtin_elementwise_fma(vb[j].zw, w0[j].zw, pb0); } }
                { __builtin_amdgcn_sched_barrier(0);
                  f32x4 w1[8];
#pragma unroll
                  for (int j = 0; j < 8; ++j) w1[j] = ((const LAS f32x4*)(wrT + (e + 8) * D))[lane + 64 * j];
#pragma unroll
                  for (int j = 0; j < 8; ++j) {
                    pa1 = __builtin_elementwise_fma(va[j].xy, w1[j].xy, pa1); pa1 = __builtin_elementwise_fma(va[j].zw, w1[j].zw, pa1);
                    pb1 = __builtin_elementwise_fma(vb[j].xy, w1[j].xy, pb1); pb1 = __builtin_elementwise_fma(vb[j].zw, w1[j].zw, pb1); } }
                const float sa0 = pa0.x + pa0.y, sb0 = pb0.x + pb0.y, sa1 = pa1.x + pa1.y, sb1 = pb1.x + pb1.y;
                { const float r = __shfl_xor(h5 ? sa0 : sa1, 32); q8a[e] = (h5 ? sa1 : sa0) + r; }
                { const float r = __shfl_xor(h5 ? sb0 : sb1, 32); q8b[e] = (h5 ? sb1 : sb0) + r; }
                __builtin_amdgcn_sched_barrier(0); }
#pragma unroll
            for (int rr = 0; rr < 2; ++rr) {
                float q8[8], q4[4], q2[2], q1;
#pragma unroll
                for (int k = 0; k < 8; ++k) q8[k] = rr ? q8b[k] : q8a[k];
#pragma unroll
                for (int k = 0; k < 4; ++k) { const float r = __shfl_xor(h4 ? q8[k] : q8[k + 4], 16); q4[k] = (h4 ? q8[k + 4] : q8[k]) + r; }
#pragma unroll
                for (int k = 0; k < 2; ++k) { const float r = __shfl_xor(h3 ? q4[k] : q4[k + 2], 8); q2[k] = (h3 ? q4[k + 2] : q4[k]) + r; }
                { const float r = __shfl_xor(h2 ? q2[0] : q2[1], 4); q1 = (h2 ? q2[1] : q2[0]) + r; }
                q1 += __shfl_xor(q1, 2); q1 += __shfl_xor(q1, 1);
                float mx = q1;
#pragma unroll
                for (int o = 4; o < 64; o <<= 1) mx = fmaxf(mx, __shfl_xor(mx, o));
                const float ex = expf(q1 - mx); float den = ex;
#pragma unroll
                for (int o = 4; o < 64; o <<= 1) den += __shfl_xor(den, o);
                const int t = (row0 + rr) % SEQ;
                if ((lane & 3) == 0) AFF[(size_t)(b * NE + (lane >> 2)) * SEQ + t] = ex / den;
            }
        }
        __syncthreads();
        if (BOTH(8)) GRID_BAR();
    }

    if (IN(9)) { PHASE_BASES();
        {
            LAS unsigned* hist = (LAS unsigned*)lds;
            LAS unsigned* shv = hist + 256;
            for (int be = bx; be < NB * NE; be += G) {
                const f32x4 va = ((const f32x4*)(AFF + (size_t)be * SEQ))[2 * tid], vb = ((const f32x4*)(AFF + (size_t)be * SEQ))[2 * tid + 1];
                float vals[8] = {va.x, va.y, va.z, va.w, vb.x, vb.y, vb.z, vb.w};
                unsigned key[8];
#pragma unroll
                for (int k = 0; k < 8; ++k) { const unsigned u = __builtin_bit_cast(unsigned, vals[k]); key[k] = (u & 0x80000000u) ? ~u : (u | 0x80000000u); }
                unsigned prefix = 0u, mask = 0u, need = (unsigned)CAP;
#pragma unroll 1
                for (int pass = 0; pass < 4; ++pass) {
                    const int shift = 24 - 8 * pass;
                    __syncthreads();
                    if (tid < 256) hist[tid] = 0u;
                    __syncthreads();
#pragma unroll
                    for (int k = 0; k < 8; ++k) if ((key[k] & mask) == prefix) __hip_atomic_fetch_add(&hist[(key[k] >> shift) & 255u], 1u, __ATOMIC_RELAXED, __HIP_MEMORY_SCOPE_WORKGROUP);
                    __syncthreads();
                    unsigned mine = 0u, incl = 0u;
                    if (wave < 4) { mine = hist[tid]; incl = mine;
#pragma unroll
                        for (int o = 1; o < 64; o <<= 1) { const unsigned t = __shfl_down(incl, o); if (lane + o < 64) incl += t; }
                        if (lane == 0) shv[24 + wave] = incl; }
                    __syncthreads();
                    if (wave < 4) { unsigned above = incl - mine;
                        for (int w = wave + 1; w < 4; ++w) above += shv[24 + w];
                        if (above < need && above + mine >= need) { shv[0] = prefix | ((unsigned)tid << shift); shv[1] = need - above; } }
                    __syncthreads();
                    prefix = shv[0]; need = shv[1]; mask |= 0xffu << shift;
                }
                const unsigned thr = prefix;
                unsigned cg_ = 0u, ce_ = 0u;
#pragma unroll
                for (int k = 0; k < 8; ++k) { cg_ += key[k] > thr ? 1u : 0u; ce_ += key[k] == thr ? 1u : 0u; }
                unsigned ig = cg_, ie = ce_;
#pragma unroll
                for (int o = 1; o < 64; o <<= 1) { const unsigned tg = __shfl_up(ig, o), te = __shfl_up(ie, o); if (lane >= o) { ig += tg; ie += te; } }
                if (lane == 63) { shv[8 + wave] = ig; shv[16 + wave] = ie; }
                __syncthreads();
                unsigned og = ig - cg_, oe = ie - ce_;
                for (int w = 0; w < wave; ++w) { og += shv[8 + w]; oe += shv[16 + w]; }
#pragma unroll
                for (int k = 0; k < 8; ++k) { const int t = 8 * tid + k; const bool gt = key[k] > thr, eq = key[k] == thr; const bool sel = gt || (eq && oe < need);
                    const unsigned slot = og + (oe < need ? oe : need);
                    if (sel) { IDX[be * CAP + slot] = (be / NE) * SEQ + t; VAL[be * CAP + slot] = vals[k]; }
                    SLOT[(size_t)be * SEQ + t] = sel ? (int)slot : -1;
                    og += gt ? 1u : 0u; oe += eq ? 1u : 0u; }
            }
            __syncthreads();
        }
        if (BOTH(9)) GRID_BAR();
    }

    if (IN(10)) { PHASE_BASES();
        pg8::Gemm g{HX2, W13, NB * NE * CAP, NE * 2 * FF, D}; OrderMoe<16> S; S.init(G, bx); EpiMoe1 E{ACT};
        pg8::gemm_phase_gather<EpiMoe1, OrderMoe<16>>(lds, g, IDX, (LAS int*)(lds + 131072), S, E);
        if (BOTH(10)) GRID_BAR();
    }

    if (IN(11)) { PHASE_BASES();
        pg8::Gemm g{ACT, W2, NB * NE * CAP, NE * D, FF}; OrderMoe<8> S; S.init(G, bx); EpiMoe2 E{OUTE, VAL};
        pg8::gemm_phase<EpiMoe2, OrderMoe<8>, true, true>(lds, g, S, E);
        if (BOTH(11)) GRID_BAR();
    }

    if (IN(12)) { PHASE_BASES();
        f32x4 pg[8];
#pragma unroll
        for (int j = 0; j < 8; ++j) pg[j] = ((const f32x4*)n_post_ffn)[lane + 64 * j];
        f32x4 pf[8]; int bcur = -1;
        int myslot = -1; f32x4 xo[8];
        if (gw < M) { const int b0 = gw / SEQ, t0 = gw % SEQ; myslot = lane < NE ? SLOT[(size_t)(b0 * NE + lane) * SEQ + t0] : -1;
#pragma unroll
            for (int j = 0; j < 8; ++j) xo[j] = __builtin_nontemporal_load((const f32x4*)(out + (size_t)gw * D) + lane + 64 * j); }
        for (int row = gw; row < M; row += NGW) {
            const int b = row / SEQ; const float* md = MODX + b * MODW;
            if (b != bcur) { bcur = b;
#pragma unroll
                for (int j = 0; j < 8; ++j) pf[j] = ((const f32x4*)(md + 5 * D))[lane + 64 * j]; }
            f32x4 acc[8];
#pragma unroll
            for (int j = 0; j < 8; ++j) acc[j] = (f32x4){0.f, 0.f, 0.f, 0.f};
            unsigned long long sel = __ballot(myslot >= 0);
            while (sel) { const int e = __builtin_ctzll(sel); sel &= sel - 1; const int s = __shfl(myslot, e);
                const v2u* src = (const v2u*)(OUTE + (size_t)((b * NE + e) * CAP + s) * D);
#pragma unroll
                for (int j = 0; j < 8; ++j) { const v2u w = __builtin_nontemporal_load(src + lane + 64 * j); acc[j] += (f32x4){bflo(w.x), bfhi(w.x), bflo(w.y), bfhi(w.y)}; } }
            float ss = 0.f;
#pragma unroll
            for (int j = 0; j < 8; ++j) ss += (acc[j].x * acc[j].x + acc[j].y * acc[j].y) + (acc[j].z * acc[j].z + acc[j].w * acc[j].w);
            const float rstd = 1.0f / sqrtf(wave_sum(ss) * (1.f / D) + EPS);
            const int nrow = row + NGW; int nslot = -1; f32x4 nxo[8];
            if (nrow < M) { const int nb = nrow / SEQ, nt = nrow % SEQ; nslot = lane < NE ? SLOT[(size_t)(nb * NE + lane) * SEQ + nt] : -1;
#pragma unroll
                for (int j = 0; j < 8; ++j) nxo[j] = __builtin_nontemporal_load((const f32x4*)(out + (size_t)nrow * D) + lane + 64 * j); }
            __builtin_amdgcn_sched_barrier(0);
#pragma unroll
            for (int j = 0; j < 8; ++j) __builtin_nontemporal_store(xo[j] + pf[j] * (acc[j] * rstd * pg[j]), (f32x4*)(out + (size_t)row * D) + lane + 64 * j);
            myslot = nslot;
#pragma unroll
            for (int j = 0; j < 8; ++j) xo[j] = nxo[j];
        }
    }
#undef in_x
#undef cvec
#undef ctx
#undef c_ctx
#undef w_mod
#undef b_mod
#undef n_pre_mix
#undef n_post_mix
#undef w_in
#undef ssd_conv_w
#undef ssd_conv_b
#undef dt_bias
#undef a_log
#undef ssd_d
#undef ssd_norm_w
#undef w_ssd_out
#undef sc_conv_w
#undef w_sc_out
#undef b_gate
#undef w_o
#undef n_pre_ffn
#undef n_post_ffn
#undef w_router
#undef w_e1
#undef w_e3
#undef w_e2
#undef out
#undef MODX
#undef MODC
#undef AFF
#undef SLOT
#undef IDX
#undef VAL
#undef DTS
#undef WIN
#undef WSSD
#undef WSC
#undef WO
#undef HX
#undef Zb
#undef XBC
#undef XBCR
#undef Gt
#undef SCY
#undef ST
#undef HENT
#undef CHLOG
#undef Yn
#undef MERGED
#undef OUTX
#undef HX2
#undef W13
#undef W2
#undef ACT
#undef OUTE
#undef KARG
#undef PHASE_BASES
#undef KAS
#undef IN
#undef BOTH
#undef GRID_BAR
}

extern "C" void kernel_launch(void* const* d_in, const int* in_sizes, int n_in, void* d_out, int out_size, void* d_ws, size_t ws_size, hipStream_t stream) {
    static int grid = 0;
    if (grid == 0) {
        if (n_in != 26 || in_sizes[0] != M * D || out_size != M * D || ws_size < WS_END) { fprintf(stderr, "kernel_launch: unexpected shapes (n_in %d, in0 %d, out %d, ws %zu < %zu); nothing launched\n", n_in, n_in > 0 ? in_sizes[0] : -1, out_size, ws_size, (size_t)WS_END); grid = -1; return; }
        int dev = 0, cus = 0, per_cu = 0;
        if (hipGetDevice(&dev) != hipSuccess || hipDeviceGetAttribute(&cus, hipDeviceAttributeMultiprocessorCount, dev) != hipSuccess) { grid = -1; return; }
        if (hipFuncSetAttribute((const void*)mk_fwd, hipFuncAttributeMaxDynamicSharedMemorySize, LDS_BYTES) != hipSuccess) { fprintf(stderr, "kernel_launch: hipFuncSetAttribute failed\n"); grid = -1; return; }
        if (hipOccupancyMaxActiveBlocksPerMultiprocessor(&per_cu, (const void*)mk_fwd, NWAVES * 64, LDS_BYTES) != hipSuccess || per_cu < 1)
            fprintf(stderr, "kernel_launch: note: occupancy query reports %d workgroups per CU\n", per_cu);
        (void)hipGetLastError();
        grid = cus;
    }
    if (grid < 0) return;
    if (hipMemsetAsync((char*)d_ws + WS_CTL, 0, CTL_ZERO_BYTES, stream) != hipSuccess) { fprintf(stderr, "kernel_launch: memset failed\n"); return; }
    Args a{};
    for (int i = 0; i < 26; ++i) a.in[i] = (const float*)d_in[i];
    a.out = (float*)d_out; a.ws = (unsigned char*)d_ws;
#if MK_N_LAUNCHES == 1
    a.ph_lo = 0; a.ph_hi = NPHASES;
    hipLaunchKernelGGL(mk_fwd, dim3(grid), dim3(NWAVES * 64), LDS_BYTES, stream, a);
#else
    for (int p = 0; p < NPHASES; ++p) { a.ph_lo = p; a.ph_hi = p + 1; hipLaunchKernelGGL(mk_fwd, dim3(grid), dim3(NWAVES * 64), LDS_BYTES, stream, a); }
#endif
    const hipError_t le = hipPeekAtLastError();
    if (le != hipSuccess) fprintf(stderr, "kernel_launch: launch failed: %s\n", hipGetErrorName(le));
}
```
